# Optimizing an MI355X kernel written in HIP

```python
import jax, jax.numpy as jnp
from jax import lax
import numpy as np

D_MODEL = 1024
BATCH = 16
SEQ = 2048
DEPTH = 2
DEC_BATCH = 8
DEC_SEQ = 32
PAST_LEN = 4096

CHUNK = 64
D_MIX = D_MODEL
D_POOL = D_MIX // 4
POOL_WINDOWS = (2, 4, 8, 16)
POOL_GROUPS = len(POOL_WINDOWS)
POOL_GC = D_POOL // POOL_GROUPS
POOL_PAD = max(POOL_WINDOWS) - 1
D_CONV = D_MIX // 4
CONV_WIDTH = 31
CONV_PAD = CONV_WIDTH - 1
D_ATT = D_MIX // 2
HEAD_DIM = 64
N_HEADS = D_ATT // HEAD_DIM
D_IN = D_POOL + 2 * D_CONV + 3 * D_ATT + N_HEADS
D_FF = 2816
QBLK = 128
EPS = 1e-6

kernel_name = "hybrid_streaming_encoder_step"


def rms_norm(x, g):
    xf = x.astype(jnp.float32)
    y = xf * lax.rsqrt(jnp.mean(xf * xf, axis=-1, keepdims=True) + EPS)
    return (y * g.astype(jnp.float32)).astype(x.dtype)


def layer_norm(x, g, b):
    xf = x.astype(jnp.float32)
    mu = jnp.mean(xf, axis=-1, keepdims=True)
    var = jnp.mean(jnp.square(xf - mu), axis=-1, keepdims=True)
    y = (xf - mu) * lax.rsqrt(var + EPS) * g.astype(jnp.float32) + b.astype(jnp.float32)
    return y.astype(x.dtype)


def swiglu_ffn(x, g, w_gu, w_down):
    h = rms_norm(x, g) @ w_gu
    a, u = jnp.split(h, 2, axis=-1)
    return (jax.nn.silu(a) * u) @ w_down


def pool_mixer(u, prev, t0, w, scale):
    B, T, C = u.shape
    seq = jnp.concatenate([prev.astype(u.dtype), u], axis=1)
    c = jnp.cumsum(seq.astype(jnp.float32), axis=1)
    c = jnp.concatenate([jnp.zeros((B, 1, C), jnp.float32), c], axis=1)
    P = POOL_PAD
    pos = t0 + jnp.arange(T)
    outs = []
    for g, wsz in enumerate(POOL_WINDOWS):
        sl = slice(g * POOL_GC, (g + 1) * POOL_GC)
        s = c[:, P + 1:P + 1 + T, sl] - c[:, P + 1 - wsz:P + 1 - wsz + T, sl]
        cnt = jnp.minimum(pos + 1, wsz).astype(jnp.float32)
        outs.append(s / cnt[None, :, None])
    pooled = jnp.concatenate(outs, axis=-1)
    d = (pooled - u.astype(jnp.float32)).astype(u.dtype).reshape(B, T, POOL_GROUPS, POOL_GC)
    y = jnp.einsum('btgc,gcd->btgd', d, w).reshape(B, T, C) * scale
    return y, seq[:, -P:]


def conv_mixer(u_glu, prev, w, b, ln_g, ln_b):
    a, gate = jnp.split(u_glu, 2, axis=-1)
    z = a * jax.nn.sigmoid(gate)
    seq = jnp.concatenate([prev.astype(z.dtype), z], axis=1)
    y = lax.conv_general_dilated(
        seq, w[:, None, :].astype(z.dtype), window_strides=(1,), padding='VALID',
        dimension_numbers=('NWC', 'WIO', 'NWC'), feature_group_count=D_CONV) + b
    y = jax.nn.silu(layer_norm(y, ln_g, ln_b))
    return y, seq[:, -CONV_PAD:]


def fox_attention(q, k, v, cq, ck, q_start):
    B, T, H, Dh = q.shape
    S = k.shape[1]
    blk = QBLK if T % QBLK == 0 else T
    nb = T // blk
    qb = q.reshape(B, nb, blk, H, Dh).swapaxes(0, 1)
    cqb = cq.reshape(B, nb, blk, H).swapaxes(0, 1)
    starts = q_start + jnp.arange(nb) * blk
    kf = k.astype(jnp.float32)
    ckT = ck.transpose(0, 2, 1)[:, :, None, :]
    kpos = jnp.arange(S)
    scale = HEAD_DIM ** -0.5

    def block(args):
        qi, ci, st = args
        s = jnp.einsum('bqhd,bkhd->bhqk', qi.astype(jnp.float32), kf) * scale
        s = s + ci.transpose(0, 2, 1)[..., None] - ckT
        qpos = st + jnp.arange(blk)
        mask = kpos[None, :] <= qpos[:, None]
        s = jnp.where(mask[None, None], s, -jnp.inf)
        p = jax.nn.softmax(s, axis=-1)
        return jnp.einsum('bhqk,bkhd->bqhd', p.astype(v.dtype), v)

    o = lax.map(block, (qb, cqb, starts))
    return o.swapaxes(0, 1).reshape(B, T, H, Dh)


def mixer_sublayer(x, prev_pool, prev_conv, k_past, v_past, logf_past, t0,
                   mix_norm, w_in, w_out, pool_w, pool_scale, conv_w, conv_b,
                   conv_ln_g, conv_ln_b, q_norm, k_norm, forget_b):
    B, T, _ = x.shape
    u = rms_norm(x, mix_norm) @ w_in
    cuts = np.cumsum([D_POOL, 2 * D_CONV, D_ATT, D_ATT, D_ATT]).tolist()
    u_pool, u_glu, u_q, u_k, u_v, u_f = jnp.split(u, cuts, axis=-1)
    y_pool, new_pool = pool_mixer(u_pool, prev_pool, t0, pool_w, pool_scale)
    y_conv, new_conv = conv_mixer(u_glu, prev_conv, conv_w, conv_b, conv_ln_g, conv_ln_b)
    q = rms_norm(u_q.reshape(B, T, N_HEADS, HEAD_DIM), q_norm)
    k = rms_norm(u_k.reshape(B, T, N_HEADS, HEAD_DIM), k_norm)
    v = u_v.reshape(B, T, N_HEADS, HEAD_DIM)
    logf = jax.nn.log_sigmoid((u_f + forget_b).astype(jnp.float32))
    if k_past is None:
        k_all, v_all, logf_all, q_start = k, v, logf, 0
    else:
        k_all = jnp.concatenate([k_past.astype(k.dtype), k], axis=1)
        v_all = jnp.concatenate([v_past.astype(v.dtype), v], axis=1)
        logf_all = jnp.concatenate([logf_past.astype(jnp.float32), logf], axis=1)
        q_start = k_past.shape[1]
    c_all = jnp.cumsum(logf_all, axis=1)
    y_att = fox_attention(q, k_all, v_all, c_all[:, q_start:], c_all, q_start)
    y = jnp.concatenate([y_pool, y_conv, y_att.reshape(B, T, D_ATT)], axis=-1) @ w_out
    return x + y, new_pool, new_conv, k, v, logf


def setup_inputs(seed: int = 0) -> dict:
    key = jax.random.key(seed)
    ks = jax.random.split(key, 26)
    nrm = jax.random.normal
    f32 = jnp.float32
    return {
        "x_prompt": nrm(ks[0], (BATCH, SEQ, D_MODEL), f32),
        "x_sample": nrm(ks[1], (DEC_BATCH, DEC_SEQ, D_MODEL), f32),
        "state_pool": nrm(ks[2], (DEPTH, DEC_BATCH, POOL_PAD, D_POOL), f32),
        "state_conv": 0.5 * nrm(ks[3], (DEPTH, DEC_BATCH, CONV_PAD, D_CONV), f32),
        "cache_k": nrm(ks[4], (DEPTH, DEC_BATCH, PAST_LEN, N_HEADS, HEAD_DIM), f32),
        "cache_v": nrm(ks[5], (DEPTH, DEC_BATCH, PAST_LEN, N_HEADS, HEAD_DIM), f32),
        "cache_logf": jax.nn.log_sigmoid(2.5 + nrm(ks[6], (DEPTH, DEC_BATCH, PAST_LEN, N_HEADS), f32)),
        "ffn1_norm": 1.0 + 0.1 * nrm(ks[7], (DEPTH, D_MODEL), f32),
        "ffn1_w_gu": nrm(ks[8], (DEPTH, D_MODEL, 2 * D_FF), f32) * D_MODEL ** -0.5,
        "ffn1_w_down": nrm(ks[9], (DEPTH, D_FF, D_MODEL), f32) * D_FF ** -0.5,
        "mix_norm": 1.0 + 0.1 * nrm(ks[10], (DEPTH, D_MODEL), f32),
        "w_in": nrm(ks[11], (DEPTH, D_MODEL, D_IN), f32) * D_MODEL ** -0.5,
        "w_out": nrm(ks[12], (DEPTH, D_MIX, D_MODEL), f32) * D_MIX ** -0.5,
        "pool_w": nrm(ks[13], (DEPTH, POOL_GROUPS, POOL_GC, POOL_GC), f32) * POOL_GC ** -0.5,
        "pool_scale": 1.0 + 0.1 * nrm(ks[14], (DEPTH, D_POOL), f32),
        "conv_w": nrm(ks[15], (DEPTH, CONV_WIDTH, D_CONV), f32) * CONV_WIDTH ** -0.5,
        "conv_b": 0.02 * nrm(ks[16], (DEPTH, D_CONV), f32),
        "conv_ln_g": 1.0 + 0.1 * nrm(ks[17], (DEPTH, D_CONV), f32),
        "conv_ln_b": 0.02 * nrm(ks[18], (DEPTH, D_CONV), f32),
        "q_norm": 1.0 + 0.1 * nrm(ks[19], (DEPTH, HEAD_DIM), f32),
        "k_norm": 1.0 + 0.1 * nrm(ks[20], (DEPTH, HEAD_DIM), f32),
        "forget_b": jax.random.uniform(ks[21], (DEPTH, N_HEADS), f32, minval=1.0, maxval=4.0),
        "ffn2_norm": 1.0 + 0.1 * nrm(ks[22], (DEPTH, D_MODEL), f32),
        "ffn2_w_gu": nrm(ks[23], (DEPTH, D_MODEL, 2 * D_FF), f32) * D_MODEL ** -0.5,
        "ffn2_w_down": nrm(ks[24], (DEPTH, D_FF, D_MODEL), f32) * D_FF ** -0.5,
    }


def reference(x_prompt, x_sample, state_pool, state_conv, cache_k, cache_v, cache_logf,
              ffn1_norm, ffn1_w_gu, ffn1_w_down, mix_norm, w_in, w_out, pool_w, pool_scale,
              conv_w, conv_b, conv_ln_g, conv_ln_b, q_norm, k_norm, forget_b,
              ffn2_norm, ffn2_w_gu, ffn2_w_down):
    xp, xs = x_prompt, x_sample
    Bp = xp.shape[0]
    pool_p, pool_s, conv_p, conv_s = [], [], [], []
    kp, vp, fp, ksl, vsl, fsl = [], [], [], [], [], []
    for l in range(DEPTH):
        mix_w = dict(mix_norm=mix_norm[l], w_in=w_in[l], w_out=w_out[l], pool_w=pool_w[l],
                     pool_scale=pool_scale[l], conv_w=conv_w[l], conv_b=conv_b[l],
                     conv_ln_g=conv_ln_g[l], conv_ln_b=conv_ln_b[l], q_norm=q_norm[l],
                     k_norm=k_norm[l], forget_b=forget_b[l])
        xp = xp + 0.5 * swiglu_ffn(xp, ffn1_norm[l], ffn1_w_gu[l], ffn1_w_down[l])
        xp, npool, nconv, nk, nv, nf = mixer_sublayer(
            xp, jnp.zeros((Bp, POOL_PAD, D_POOL), xp.dtype), jnp.zeros((Bp, CONV_PAD, D_CONV), xp.dtype),
            None, None, None, 0, **mix_w)
        xp = xp + 0.5 * swiglu_ffn(xp, ffn2_norm[l], ffn2_w_gu[l], ffn2_w_down[l])
        pool_p.append(npool); conv_p.append(nconv); kp.append(nk); vp.append(nv); fp.append(nf)
        xs = xs + 0.5 * swiglu_ffn(xs, ffn1_norm[l], ffn1_w_gu[l], ffn1_w_down[l])
        xs, npool, nconv, nk, nv, nf = mixer_sublayer(
            xs, state_pool[l], state_conv[l], cache_k[l], cache_v[l], cache_logf[l],
            cache_k.shape[2], **mix_w)
        xs = xs + 0.5 * swiglu_ffn(xs, ffn2_norm[l], ffn2_w_gu[l], ffn2_w_down[l])
        pool_s.append(npool); conv_s.append(nconv); ksl.append(nk); vsl.append(nv); fsl.append(nf)
    return (xp, xs,
            jnp.stack(pool_p), jnp.stack(pool_s),
            jnp.stack(conv_p), jnp.stack(conv_s),
            jnp.stack(kp), jnp.stack(vp), jnp.stack(fp),
            jnp.stack(ksl), jnp.stack(vsl), jnp.stack(fsl))
```

```cpp
#include <hip/hip_runtime.h>
#include <hip/hip_bf16.h>
#include <hip/hip_cooperative_groups.h>
#include <cstdio>
#include <cstdint>
#include <cmath>
namespace cg = cooperative_groups;
namespace pg8 {
#define PG8_LAS __attribute__((address_space(3)))
typedef unsigned short bf16_t;
typedef short bf16x8 __attribute__((ext_vector_type(8)));
typedef float f32x4 __attribute__((ext_vector_type(4)));
typedef unsigned u32x4 __attribute__((ext_vector_type(4)));
constexpr int BM = 256, BK = 64, HALF = 128, HTB = HALF * BK * 2  , STAGE_BYTES = 8 * HTB, NXCD = 8, WGM = 8;

__host__ __device__ __forceinline__ int lds_byte(int r, int c) { const int st = (r >> 4) * 2 + (c >> 5), rr = r & 15, cc = c & 31, ob = rr * 64 + cc * 2; return st * 1024 + (ob ^ (((ob >> 9) & 1) << 5)); }
__host__ __device__ __forceinline__ void stage_rc(int b, int& R, int& C) { const int st = b / 1024, sb = b % 1024, swz = sb ^ (((sb >> 9) & 1) << 5); R = (st >> 1) * 16 + swz / 64; C = (st & 1) * 32 + (swz % 64) / 2; }
__host__ __device__ __forceinline__ int perm32(int rho) { const int n = rho >> 4, i = rho & 15; return 8 * (i >> 2) + 4 * n + (i & 3); }

struct Unit { int pm, pn, ko; };
struct Gemm { const bf16_t* A; const bf16_t* Bt; int M, N, K, ld; };

struct StaticOrder {
    int nM, nN, nwg, G, c;
    __host__ __device__ void init(int M, int N, int G_, int c_) { nM = M / BM; nN = N / BM; nwg = nM * nN; G = G_; c = c_; }
    __host__ __device__ bool next(int i, Unit& u) const {
        const long L = (long)i * G + c; if (L >= nwg) return false;
        int wgid = (int)L; { const int q = nwg / NXCD, r = nwg % NXCD, xcd = wgid % NXCD, off = wgid / NXCD; wgid = (xcd < r ? xcd * (q + 1) : r * (q + 1) + (xcd - r) * q) + off; }
        const int nig = WGM * nN, gid = wgid / nig, fm = gid * WGM, gsz = (nM - fm) < WGM ? (nM - fm) : WGM;
        u.pm = fm + ((wgid % nig) % gsz); u.pn = (wgid % nig) / gsz; u.ko = 0; return true;
    }
    __device__ __forceinline__ void a_ready(const Unit&) const {}
    __device__ __forceinline__ void done(const Unit&) const {}
};

__device__ __forceinline__ unsigned cvt_pk_bf16(float lo, float hi) { unsigned r; asm volatile("v_cvt_pk_bf16_f32 %0, %1, %2" : "=v"(r) : "v"(lo), "v"(hi)); return r; }
typedef float f32x2 __attribute__((ext_vector_type(2)));
template <class Epi, class Sched, bool ALIGN_EPI = false, bool SP2 = false>
__device__ __forceinline__ void gemm_phase(PG8_LAS unsigned char* lds, const Gemm g, const Sched& S, const Epi& E) {
    int tid = threadIdx.x; asm volatile("" : "+v"(tid));
    const int wid = __builtin_amdgcn_readfirstlane(tid >> 6), lane = tid & 63, wr = wid >> 2, wc = wid & 3, fr = lane & 15, fq = lane >> 4;
    const int K = g.K, nt = K / BK;
    unsigned voffA[2], voffB[2];
#pragma unroll
    for (int i = 0; i < 2; ++i) { int R, C; stage_rc(tid * 16 + i * 8192, R, C); const int Rb = Epi::PERM ? ((R & ~31) + perm32(R & 31)) : R;
        voffA[i] = (unsigned)(R * g.ld + C) * 2u; voffB[i] = (unsigned)(Rb * g.ld + C) * 2u; }
    const size_t kstep = (size_t)(BK * 2);
    const size_t hstep = (size_t)HALF * g.ld * 2;
    const size_t tstep = 2 * hstep;
    const unsigned ldsw = (unsigned)wid * 1024u;
    const int aoff = lds_byte(wr * 64 + fr, fq * 8), boff = lds_byte(wc * 32 + fr, fq * 8);
#define PG8_SA(b, h) (((b) * 2 + (h)) * HTB)
#define PG8_SB(b, h) ((4 + (b) * 2 + (h)) * HTB)
#define PG8_STAGE(bufoff, gbase, voff) do { _Pragma("unroll") for (int _i = 0; _i < 2; ++_i) \
        __builtin_amdgcn_global_load_lds((const unsigned*)((const char*)(gbase) + (voff)[_i]), (PG8_LAS unsigned*)(lds + (bufoff) + ldsw + _i * 8192), 16, 0, 0); } while (0)
#define PG8_LDA(dst, b, h) do { _Pragma("unroll") for (int m = 0; m < 4; ++m) _Pragma("unroll") for (int k = 0; k < 2; ++k) dst[m][k] = *(const PG8_LAS bf16x8*)(lds + PG8_SA(b, h) + aoff + m * 2048 + k * 1024); } while (0)
#define PG8_LDB(dst, b, h) do { _Pragma("unroll") for (int n = 0; n < 2; ++n) _Pragma("unroll") for (int k = 0; k < 2; ++k) dst[n][k] = *(const PG8_LAS bf16x8*)(lds + PG8_SB(b, h) + boff + n * 2048 + k * 1024); } while (0)
#define PG8_MMA(ai, bj, At, Bt) do { __builtin_amdgcn_s_setprio(1); _Pragma("unroll") for (int m = 0; m < 4; ++m) _Pragma("unroll") for (int n = 0; n < 2; ++n) _Pragma("unroll") for (int k = 0; k < 2; ++k) \
        acc[ai][bj][m][n] = __builtin_amdgcn_mfma_f32_16x16x32_bf16(Bt[n][k], At[m][k], acc[ai][bj][m][n], 0, 0, 0); __builtin_amdgcn_s_setprio(0); } while (0)
#define PG8_WAIT_V(n) asm volatile("s_waitcnt vmcnt(" #n ")" ::: "memory")
#define PG8_WAIT_L(n) asm volatile("s_waitcnt lgkmcnt(" #n ")" ::: "memory")
#define PG8_BAR __builtin_amdgcn_s_barrier()
#define PG8_SCHED __builtin_amdgcn_sched_barrier(0)
    Unit cur, nxt; int ui = 0;
    if (!S.next(0, cur)) return;
    f32x4 acc[2][2][4][2];
#pragma unroll
    for (int a = 0; a < 2; ++a)
#pragma unroll
        for (int b = 0; b < 2; ++b)
#pragma unroll
            for (int m = 0; m < 4; ++m)
#pragma unroll
                for (int n = 0; n < 2; ++n) acc[a][b][m][n] = (f32x4){0.f, 0.f, 0.f, 0.f};
    bf16x8 At[4][2], B0[2][2], B1[2][2];
    const char* cA = (const char*)g.A + (size_t)cur.pm * tstep + (size_t)cur.ko * 2; const char* cB = (const char*)g.Bt + (size_t)cur.pn * tstep + (size_t)cur.ko * 2;
    S.a_ready(cur);
    if constexpr (SP2) {
        PG8_STAGE(PG8_SB(0, 0), cB, voffB); PG8_STAGE(PG8_SB(0, 1), cB + hstep, voffB); PG8_STAGE(PG8_SA(0, 0), cA, voffA); PG8_STAGE(PG8_SA(0, 1), cA + hstep, voffA);
        if (wr == 1) PG8_BAR;
        PG8_WAIT_V(2); PG8_BAR;
        PG8_STAGE(PG8_SB(1, 0), cB + kstep, voffB); PG8_STAGE(PG8_SA(1, 0), cA + kstep, voffA); PG8_STAGE(PG8_SB(1, 1), cB + hstep + kstep, voffB);
        PG8_WAIT_V(6); PG8_BAR;
    } else {
        PG8_STAGE(PG8_SB(0, 0), cB, voffB); PG8_STAGE(PG8_SA(0, 0), cA, voffA); PG8_STAGE(PG8_SB(0, 1), cB + hstep, voffB); PG8_STAGE(PG8_SA(0, 1), cA + hstep, voffA);
        if (wr == 1) PG8_BAR;
        PG8_WAIT_V(4); PG8_BAR;
        PG8_STAGE(PG8_SB(1, 0), cB + kstep, voffB); PG8_STAGE(PG8_SA(1, 0), cA + kstep, voffA); PG8_STAGE(PG8_SB(1, 1), cB + hstep + kstep, voffB);
        PG8_WAIT_V(6); PG8_BAR;
    }
    for (;;) {
        const bool has_next = S.next(ui + 1, nxt);
        const char* nA = has_next ? (const char*)g.A + (size_t)nxt.pm * tstep + (size_t)nxt.ko * 2 : cA; const char* nB = has_next ? (const char*)g.Bt + (size_t)nxt.pn * tstep + (size_t)nxt.ko * 2 : cB;
        for (int t = 0; t < nt; t += 2) {
            const bool last = (t == nt - 2);
            const char* a1 = cA + (size_t)(t + 1) * kstep;
            const char* a2 = last ? nA : cA + (size_t)(t + 2) * kstep; const char* b2 = last ? nB : cB + (size_t)(t + 2) * kstep;
            const char* a3 = a2 + kstep; const char* b3 = b2 + kstep;
            if (last && has_next) S.a_ready(nxt);
            if constexpr (SP2) {
            PG8_LDB(B0, 0, 0); PG8_LDB(B1, 0, 1); PG8_SCHED; PG8_LDA(At, 0, 0); PG8_STAGE(PG8_SA(1, 1), a1 + hstep, voffA);
            PG8_WAIT_V(8); PG8_WAIT_L(0); PG8_BAR; PG8_MMA(0, 0, At, B0); PG8_MMA(0, 1, At, B1); PG8_BAR; PG8_SCHED;
            PG8_LDA(At, 0, 1); PG8_STAGE(PG8_SB(0, 0), b2, voffB); PG8_STAGE(PG8_SB(0, 1), b2 + hstep, voffB); PG8_STAGE(PG8_SA(0, 0), a2, voffA);
            PG8_WAIT_V(8); PG8_WAIT_L(0); PG8_BAR; PG8_MMA(1, 0, At, B0); PG8_MMA(1, 1, At, B1); PG8_BAR; PG8_SCHED;
            PG8_LDB(B0, 1, 0); PG8_LDB(B1, 1, 1); PG8_SCHED; PG8_LDA(At, 1, 0); PG8_STAGE(PG8_SA(0, 1), a2 + hstep, voffA);
            PG8_WAIT_V(8); PG8_WAIT_L(0); PG8_BAR; PG8_MMA(0, 0, At, B0); PG8_MMA(0, 1, At, B1); PG8_BAR; PG8_SCHED;
            PG8_LDA(At, 1, 1); PG8_STAGE(PG8_SB(1, 0), b3, voffB); PG8_STAGE(PG8_SB(1, 1), b3 + hstep, voffB); PG8_STAGE(PG8_SA(1, 0), a3, voffA);
            PG8_WAIT_V(8); PG8_WAIT_L(0); PG8_BAR; PG8_MMA(1, 0, At, B0); PG8_MMA(1, 1, At, B1); PG8_BAR; PG8_SCHED;
            } else {
            PG8_LDB(B0, 0, 0); PG8_SCHED; PG8_LDA(At, 0, 0); PG8_STAGE(PG8_SA(1, 1), a1 + hstep, voffA);
            PG8_WAIT_L(8); PG8_BAR; PG8_WAIT_L(0); PG8_MMA(0, 0, At, B0); PG8_BAR; PG8_SCHED;
            PG8_LDB(B1, 0, 1); PG8_STAGE(PG8_SB(0, 0), b2, voffB);
            PG8_BAR; PG8_WAIT_L(0); PG8_MMA(0, 1, At, B1); PG8_BAR;
            PG8_LDA(At, 0, 1); PG8_STAGE(PG8_SA(0, 0), a2, voffA);
            PG8_BAR; PG8_WAIT_L(0); PG8_MMA(1, 0, At, B0); PG8_BAR; PG8_SCHED;
            PG8_STAGE(PG8_SB(0, 1), b2 + hstep, voffB);
            PG8_WAIT_V(6); PG8_BAR; PG8_MMA(1, 1, At, B1); PG8_BAR;
            PG8_LDB(B0, 1, 0); PG8_SCHED; PG8_LDA(At, 1, 0); PG8_STAGE(PG8_SA(0, 1), a2 + hstep, voffA);
            PG8_WAIT_L(8); PG8_BAR; PG8_WAIT_L(0); PG8_MMA(0, 0, At, B0); PG8_BAR; PG8_SCHED;
            PG8_LDB(B1, 1, 1); PG8_STAGE(PG8_SB(1, 0), b3, voffB);
            PG8_BAR; PG8_WAIT_L(0); PG8_MMA(0, 1, At, B1); PG8_BAR;
            PG8_LDA(At, 1, 1); PG8_STAGE(PG8_SA(1, 0), a3, voffA);
            PG8_BAR; PG8_WAIT_L(0); PG8_MMA(1, 0, At, B0); PG8_BAR; PG8_SCHED;
            PG8_STAGE(PG8_SB(1, 1), b3 + hstep, voffB);
            PG8_WAIT_V(6); PG8_BAR; PG8_MMA(1, 1, At, B1); PG8_BAR;
            }
        }
        if constexpr (ALIGN_EPI) { if (wr == 0) PG8_BAR; }
        if constexpr (!Epi::AFTER_DRAIN) { E(acc, cur, wr, wc, fr, fq); S.done(cur); }
        if (!has_next) break;
#pragma unroll
        for (int a = 0; a < 2; ++a)
#pragma unroll
            for (int b = 0; b < 2; ++b)
#pragma unroll
                for (int m = 0; m < 4; ++m)
#pragma unroll
                    for (int n = 0; n < 2; ++n) acc[a][b][m][n] = (f32x4){0.f, 0.f, 0.f, 0.f};
        cur = nxt; cA = nA; cB = nB; ++ui;
        if constexpr (ALIGN_EPI) { if (wr == 1) PG8_BAR; }
    }
    PG8_WAIT_V(0);
    if constexpr (!ALIGN_EPI) { if (wr == 0) PG8_BAR; }
    PG8_BAR;
    if constexpr (Epi::AFTER_DRAIN) { E.fused(acc, cur, wr, wc, fr, fq, lds, wid, lane); S.done(cur); }
#undef PG8_SA
#undef PG8_SB
#undef PG8_STAGE
#undef PG8_LDA
#undef PG8_LDB
#undef PG8_MMA
#undef PG8_WAIT_V
#undef PG8_WAIT_L
#undef PG8_BAR
#undef PG8_SCHED
}
}
namespace pg8 {
constexpr size_t MIX_MiB = 1u << 20, MIX_UP = 280 * MIX_MiB, MIX_Z = 313 * MIX_MiB, MIX_QP = 346 * MIX_MiB, MIX_KP = 378 * MIX_MiB, MIX_VP = 410 * MIX_MiB, MIX_QS = 278 * MIX_MiB, MIX_KS = 146 * MIX_MiB, MIX_KSS = 33 * MIX_MiB;
constexpr size_t MIX_OKP = 34369536, MIX_OVP = 67923968, MIX_OKS = 102002688, MIX_OVS = 102264832;
typedef unsigned u32x2 __attribute__((ext_vector_type(2)));
__device__ __forceinline__ float sigmoid_f(float x) { return __builtin_amdgcn_rcpf(1.0f + __expf(-x)); }
struct EpiSwiglu {
    static constexpr bool PERM = true, AFTER_DRAIN = false;
    bf16_t* H; int ldh;
    __device__ __forceinline__ void operator()(const f32x4 (&acc)[2][2][4][2], const Unit& u, int wr, int wc, int fr, int fq) const {
        int rb = wr * 64 + fr; asm volatile("" : "+v"(rb));
        const int row0 = u.pm * BM + rb, col0 = u.pn * 128 + wc * 32 + 8 * fq;
#pragma unroll
        for (int ai = 0; ai < 2; ++ai)
#pragma unroll
            for (int m = 0; m < 4; ++m) { bf16_t* rowp = H + (size_t)(row0 + ai * HALF + m * 16) * ldh + col0; u32x4 w;
#pragma unroll
                for (int n = 0; n < 2; ++n) { const f32x4 a = acc[ai][0][m][n], g = acc[ai][1][m][n];
                    const float h0 = a[0] * sigmoid_f(a[0]) * g[0], h1 = a[1] * sigmoid_f(a[1]) * g[1], h2 = a[2] * sigmoid_f(a[2]) * g[2], h3 = a[3] * sigmoid_f(a[3]) * g[3];
                    if (n == 0) { w.x = cvt_pk_bf16(h0, h1); w.y = cvt_pk_bf16(h2, h3); } else { w.z = cvt_pk_bf16(h0, h1); w.w = cvt_pk_bf16(h2, h3); } }
                *(u32x4*)rowp = w; }
    }
};
struct EpiResid {
    static constexpr bool PERM = true, AFTER_DRAIN = false;
    const float* B; float* X; int ldc; float alpha;
    __device__ __forceinline__ void operator()(const f32x4 (&acc)[2][2][4][2], const Unit& u, int wr, int wc, int fr, int fq) const {
        int rb = wr * 64 + fr; asm volatile("" : "+v"(rb));
        const int row0 = u.pm * BM + rb, col0 = u.pn * BM + wc * 32 + 8 * fq;
#pragma unroll
        for (int ai = 0; ai < 2; ++ai)
#pragma unroll
            for (int m = 0; m < 4; ++m) { const size_t ro = (size_t)(row0 + ai * HALF + m * 16) * ldc + col0;
#pragma unroll
                for (int bj = 0; bj < 2; ++bj)
#pragma unroll
                    for (int n = 0; n < 2; ++n) { const f32x4 o = *(const f32x4*)(B + ro + bj * HALF + n * 4) + acc[ai][bj][m][n] * alpha; *(f32x4*)(X + ro + bj * HALF + n * 4) = o; } }
    }
};
struct EpiMixIn {
    static constexpr bool PERM = true, AFTER_DRAIN = false;
    unsigned char* ws; float* out; const float *qn, *kn; int l; float c2;
    __device__ __forceinline__ void operator()(const f32x4 (&acc)[2][2][4][2], const Unit& u, int wr, int wc, int fr, int fq) const {
        const int pn = u.pn; const bool samp = (u.pm == 128);
        int rbase = wr * 64 + fr; asm volatile("" : "+v"(rbase));
        if (pn == 0) {
            float* UP = (float*)(ws + MIX_UP) + ((size_t)u.pm * BM + rbase) * 256 + wc * 32 + 8 * fq;
#pragma unroll
            for (int ai = 0; ai < 2; ++ai)
#pragma unroll
                for (int m = 0; m < 4; ++m) { float* p = UP + (size_t)(ai * HALF + m * 16) * 256;
#pragma unroll
                    for (int bj = 0; bj < 2; ++bj)
#pragma unroll
                        for (int n = 0; n < 2; ++n) *(f32x4*)(p + bj * HALF + n * 4) = acc[ai][bj][m][n];
                    asm volatile("" ::: "memory"); }
        } else if (pn <= 2) {
            float* Z = (float*)(ws + MIX_Z) + ((size_t)u.pm * BM + rbase) * 256 + (pn - 1) * 128 + wc * 32 + 8 * fq;
#pragma unroll
            for (int ai = 0; ai < 2; ++ai)
#pragma unroll
                for (int m = 0; m < 4; ++m) { float* p = Z + (size_t)(ai * HALF + m * 16) * 256;
#pragma unroll
                    for (int n = 0; n < 2; ++n) { const f32x4 a = acc[ai][0][m][n], g = acc[ai][1][m][n]; f32x4 z;
                        z[0] = a[0] * sigmoid_f(g[0]); z[1] = a[1] * sigmoid_f(g[1]); z[2] = a[2] * sigmoid_f(g[2]); z[3] = a[3] * sigmoid_f(g[3]); *(f32x4*)(p + n * 4) = z; }
                    asm volatile("" ::: "memory"); }
        } else {
            const int s = (pn - 3) >> 1, head = 4 * ((pn - 3) & 1) + wc;
            bf16_t* bbase; float* fbase;
            if (!samp) { const size_t g0 = (size_t)u.pm * BM * 512;
                bbase = (bf16_t*)(ws + (s == 0 ? MIX_QP : s == 1 ? MIX_KP : MIX_VP)) + g0; fbase = out + (s == 1 ? MIX_OKP : MIX_OVP) + (size_t)l * 32768 * 512 + g0;
            } else {
                bbase = (s == 0) ? (bf16_t*)(ws + MIX_QS) + 128 * 512 : (bf16_t*)(ws + MIX_KS + (size_t)(2 * l + (s - 1)) * MIX_KSS) + (size_t)4096 * 512;
                fbase = out + (s == 1 ? MIX_OKS : MIX_OVS) + (size_t)l * 256 * 512; }
            const int bstride = samp ? (s == 0 ? 256 : 4224) : 32;
            const float* gn = (s == 0) ? qn : kn;
#pragma unroll
            for (int ai = 0; ai < 2; ++ai)
#pragma unroll
                for (int m = 0; m < 4; ++m) {
                    const int r = ai * HALF + m * 16 + rbase;
                    float sc = 1.0f;
                    if (s < 2) { float ss = 0.f;
#pragma unroll
                        for (int bj = 0; bj < 2; ++bj)
#pragma unroll
                            for (int n = 0; n < 2; ++n) { const f32x4 x = acc[ai][bj][m][n]; ss += (x[0] * x[0] + x[1] * x[1]) + (x[2] * x[2] + x[3] * x[3]); }
                        ss += __shfl_xor(ss, 16); ss += __shfl_xor(ss, 32);
                        sc = rsqrtf(ss * (1.0f / 64.0f) + 1e-6f); if (s == 0) sc *= c2; }
                    asm volatile("" : "+v"(sc));
                    bf16_t* bdst = bbase + ((size_t)(r >> 5) * bstride + (r & 31)) * 512 + head * 64 + 8 * fq;
                    float* fdst = fbase + (size_t)r * 512 + head * 64 + 8 * fq;
#pragma unroll
                    for (int bj = 0; bj < 2; ++bj) { u32x4 w;
#pragma unroll
                        for (int n = 0; n < 2; ++n) { const int dim = 32 * bj + 4 * n; f32x4 x = acc[ai][bj][m][n];
                            if (s < 2) { const f32x4 g = *(const f32x4*)(gn + dim + 8 * fq); x = x * g * sc; }
                            if (s >= 1) *(f32x4*)(fdst + dim) = x;
                            if (n == 0) { w.x = cvt_pk_bf16(x[0], x[1]); w.y = cvt_pk_bf16(x[2], x[3]); } else { w.z = cvt_pk_bf16(x[0], x[1]); w.w = cvt_pk_bf16(x[2], x[3]); } }
                        *(u32x4*)(bdst + 32 * bj) = w; }
                    asm volatile("" ::: "memory"); }
        }
    }
};
struct SplitOrder {
    int nN, nk, kc, pm, c;
    __device__ bool next(int i, Unit& u) const { if (i > 0 || c >= nN * nk) return false; u.pm = pm; u.pn = c % nN; u.ko = (c / nN) * kc; return true; }
    __device__ __forceinline__ void a_ready(const Unit&) const {}
    __device__ __forceinline__ void done(const Unit&) const {}
};
struct EpiResidAtomic {
    static constexpr bool PERM = false, AFTER_DRAIN = false;
    float* X; int ldc; float alpha;
    __device__ __forceinline__ void operator()(const f32x4 (&acc)[2][2][4][2], const Unit& u, int wr, int wc, int fr, int fq) const {
        int rb = wr * 64 + fr; asm volatile("" : "+v"(rb));
        const int row0 = u.pm * BM + rb, col0 = u.pn * BM + wc * 32 + 4 * fq;
#pragma unroll
        for (int ai = 0; ai < 2; ++ai)
#pragma unroll
            for (int m = 0; m < 4; ++m) { float* rowp = X + (size_t)(row0 + ai * HALF + m * 16) * ldc + col0;
#pragma unroll
                for (int bj = 0; bj < 2; ++bj)
#pragma unroll
                    for (int n = 0; n < 2; ++n) { float* p = rowp + bj * HALF + n * 16; const f32x4 v = acc[ai][bj][m][n] * alpha;
                        atomicAdd(p, v[0]); atomicAdd(p + 1, v[1]); atomicAdd(p + 2, v[2]); atomicAdd(p + 3, v[3]); }
                asm volatile("" ::: "memory"); }
    }
};
}
namespace attn_body {
using bf16=__hip_bfloat16;
using bf16x8=__attribute__((ext_vector_type(8)))short;
using s16x4=__attribute__((ext_vector_type(4)))short;
using f32x16=__attribute__((ext_vector_type(16)))float;
using u32x4=__attribute__((ext_vector_type(4)))unsigned;
constexpr int D=64,KVP=512,OP=1024;
typedef float f32x4_t __attribute__((ext_vector_type(4)));
typedef __attribute__((address_space(3))) const float* lds_cfptr;
constexpr int NW=8,QBLK=32,QB=QBLK*NW,KVBLK=64;
__device__ __forceinline__ int crow(int r,int hi){return (r&3)+8*(r>>2)+4*hi;}
#define SBAR() __builtin_amdgcn_sched_barrier(0)
__device__ __forceinline__ void cmask(f32x16&p0,f32x16&p1,int jb,int qrel,int hi){
  const float NEG=-INFINITY; int kb=64*jb+4*hi;
  #pragma unroll
  for(int r=0;r<16;++r){int kv=kb+(r&3)+8*(r>>2); if(kv>qrel)p0[r]=NEG; if(kv+32>qrel)p1[r]=NEG;}
}

constexpr int NSLOT=3, SLOTB=8192;
constexpr int LDS_K=0, LDS_V=NSLOT*SLOTB, LDS_WS=2*NSLOT*SLOTB, LDS_OST=LDS_WS+NW*64*4, LDS_BYTES=LDS_OST+NW*4096;
constexpr float C2=0.125f*1.4426950408889634f;
__device__ __forceinline__ void glds16(const void*gsrc,unsigned lds_dst){unsigned keep;
  asm volatile("s_mov_b32 %0, m0\n\ts_mov_b32 m0, %2\n\ts_nop 0\n\tglobal_load_lds_dwordx4 %1, off\n\ts_mov_b32 m0, %0":"=&s"(keep):"v"(gsrc),"s"(lds_dst):"memory");}
__device__ __forceinline__ float max3f(float a,float b,float c){float r;asm("v_max3_f32 %0, %1, %2, %3":"=v"(r):"v"(a),"v"(b),"v"(c));return r;}
__device__ __forceinline__ float max2f(float a,float b){float r;asm("v_max_f32_e32 %0, %1, %2":"=v"(r):"v"(a),"v"(b));return r;}
__device__ __forceinline__ float fadd_s(float a,float b){float r;asm("v_add_f32_e32 %0, %1, %2":"=v"(r):"v"(a),"v"(b));return r;}
__device__ __forceinline__ float fsub_s(float a,float b){float r;asm("v_sub_f32_e32 %0, %1, %2":"=v"(r):"v"(a),"v"(b));return r;}
typedef float f32x2_t __attribute__((ext_vector_type(2))); typedef __bf16 bf16x2_t __attribute__((ext_vector_type(2)));
__device__ __forceinline__ unsigned cvtpk_s(float lo,float hi){f32x2_t v={lo,hi};bf16x2_t b=__builtin_convertvector(v,bf16x2_t);return __builtin_bit_cast(unsigned,b);}
#define WAIT_BAR(N) asm volatile("s_waitcnt vmcnt(" #N ") lgkmcnt(0)\n\ts_barrier":::"memory")

__device__ __forceinline__ void qkt(f32x16&p0,f32x16&p1,const char*Kslot,const bf16x8*qr,int r32,int hi){
  const char*kb=Kslot+hi*1024+r32*16;
  #pragma unroll
  for(int d0=0;d0<4;++d0){
    const bf16x8 b0=*reinterpret_cast<const bf16x8*>(kb+d0*2048);
    const bf16x8 b1=*reinterpret_cast<const bf16x8*>(kb+d0*2048+512);
    p0=__builtin_amdgcn_mfma_f32_32x32x16_bf16(b0,qr[d0],p0,0,0,0);p1=__builtin_amdgcn_mfma_f32_32x32x16_bf16(b1,qr[d0],p1,0,0,0);}
}
typedef __attribute__((address_space(3))) const char* lds_cptr;
typedef short v4i16_t __attribute__((ext_vector_type(4)));
__device__ __forceinline__ void kload8(bf16x8*kf,lds_cptr kp){
  kf[0]=*(const __attribute__((address_space(3))) bf16x8*)(kp);      kf[1]=*(const __attribute__((address_space(3))) bf16x8*)(kp+512);
  kf[2]=*(const __attribute__((address_space(3))) bf16x8*)(kp+2048); kf[3]=*(const __attribute__((address_space(3))) bf16x8*)(kp+2560);
  kf[4]=*(const __attribute__((address_space(3))) bf16x8*)(kp+4096); kf[5]=*(const __attribute__((address_space(3))) bf16x8*)(kp+4608);
  kf[6]=*(const __attribute__((address_space(3))) bf16x8*)(kp+6144); kf[7]=*(const __attribute__((address_space(3))) bf16x8*)(kp+6656);
}
__device__ __forceinline__ void kload2(bf16x8*kf,lds_cptr kp,int j){ kf[2*j]=*(const __attribute__((address_space(3))) bf16x8*)(kp+j*2048); kf[2*j+1]=*(const __attribute__((address_space(3))) bf16x8*)(kp+j*2048+512); }
__device__ __forceinline__ s16x4 vtr(lds_cptr p){ return __builtin_bit_cast(s16x4,__builtin_amdgcn_ds_read_tr16_b64_v4i16((__attribute__((address_space(3))) v4i16_t*)p)); }
__device__ __forceinline__ float rowmax(const f32x16&p0,const f32x16&p1){
  float a=max3f(p0[0],p0[1],p1[0]),b=max3f(p0[2],p0[3],p1[1]);a=max3f(a,p1[2],p1[3]);
  #pragma unroll
  for(int r=4;r<16;r+=4){a=max3f(a,p0[r],p0[r+1]);b=max3f(b,p0[r+2],p0[r+3]);a=max3f(a,p1[r],p1[r+1]);b=max3f(b,p1[r+2],p1[r+3]);}
  const float m=max2f(a,b);
  auto rr=__builtin_amdgcn_permlane32_swap(__float_as_uint(m),__float_as_uint(m),false,false);
  return max2f(__uint_as_float(rr[0]),__uint_as_float(rr[1]));
}
__device__ __forceinline__ void pv(f32x16*o,int vb,bf16x8 pa0,bf16x8 pa1,bf16x8 pa2,bf16x8 pa3){
  #pragma unroll
  for(int d0=0;d0<2;++d0){s16x4 lo[4],hi[4];
    #pragma unroll
    for(int ks=0;ks<4;++ks){
      asm volatile("ds_read_b64_tr_b16 %0,%1 offset:%c2":"=&v"(lo[ks]):"v"(vb),"i"(d0*4096+ks*1024):"memory");
      asm volatile("ds_read_b64_tr_b16 %0,%1 offset:%c2":"=&v"(hi[ks]):"v"(vb),"i"(d0*4096+ks*1024+512):"memory");}
    asm volatile("s_waitcnt lgkmcnt(0)":::"memory");SBAR();
    #define PK(k) (bf16x8){lo[k][0],lo[k][1],lo[k][2],lo[k][3],hi[k][0],hi[k][1],hi[k][2],hi[k][3]}
    o[d0]=__builtin_amdgcn_mfma_f32_32x32x16_bf16(pa0,PK(0),o[d0],0,0,0);
    o[d0]=__builtin_amdgcn_mfma_f32_32x32x16_bf16(pa1,PK(1),o[d0],0,0,0);
    o[d0]=__builtin_amdgcn_mfma_f32_32x32x16_bf16(pa2,PK(2),o[d0],0,0,0);
    o[d0]=__builtin_amdgcn_mfma_f32_32x32x16_bf16(pa3,PK(3),o[d0],0,0,0);
    #undef PK
  }
}

#ifndef ATTN_STORE16
#define ATTN_STORE16(p,v) (*(u32x4*)(p)=(v))
#endif
template<int THRL> __device__ __forceinline__ void attn_unit(const bf16*Qu,const bf16*__restrict__ Kh,const bf16*__restrict__ Vh,bf16*Ou,const int NT,const int store_mask,lds_cfptr ck2,char*shm){
  int tid=threadIdx.x; asm volatile("":"+v"(tid)); const int lane=tid&63,r32=lane&31,hi=lane>>5; const int wid=__builtin_amdgcn_readfirstlane(tid>>6);
  const bf16*Qw=Qu+(long)(wid*QBLK)*KVP;
  const unsigned lds0=(unsigned)(uintptr_t)shm;
  float*wsf=(float*)(shm+LDS_WS)+wid*64;
  const bf16*ksrc=Kh+(long)lane*KVP+wid*8;
  const bf16*vsrc=Vh+(long)(16*(wid&3)+(lane>>2))*KVP+(wid>>2)*32+(lane&3)*8;
  const unsigned kdst=lds0+LDS_K+wid*1024, vdst=lds0+LDS_V+wid*1024;
  #define DMA_K(t,slot) glds16(ksrc+(long)(t)*KVBLK*KVP,(unsigned)__builtin_amdgcn_readfirstlane(kdst+(slot)))
  #define DMA_V(t,slot) glds16(vsrc+(long)(t)*KVBLK*KVP,(unsigned)__builtin_amdgcn_readfirstlane(vdst+(slot)))
  const int vb0=(int)(lds0+LDS_V)+((lane>>4)&1)*32+(lane&3)*8+(4*hi+((lane&15)>>2))*64;
  const char*Kbase=shm+LDS_K; bf16x8 kf[8];
  const lds_cptr shm3=(lds_cptr)shm; const lds_cptr kp0=shm3+LDS_K+hi*1024+r32*16; const lds_cptr vp0=shm3+LDS_V+((lane>>4)&1)*32+(lane&3)*8+(4*hi+((lane&15)>>2))*64;
  DMA_K(0,0);DMA_V(0,0);DMA_K(1,SLOTB);
  bf16x8 qr[4];
  #pragma unroll
  for(int d0=0;d0<4;++d0)qr[d0]=*reinterpret_cast<const bf16x8*>(&Qw[(long)r32*KVP+d0*16+hi*8]);
  float mhat=0.f,l_reg=0.f;f32x16 o[2];o[0]=f32x16{};o[1]=f32x16{};
  const int qrel=wid*QBLK+r32;
  #define PREFILL(P0,P1,t) do{ const lds_cfptr cb_=ck2+64*(t)+4*hi; const float nm_=-mhat; \
    _Pragma("unroll") for(int j_=0;j_<4;++j_){ const f32x4_t a_=*(const __attribute__((address_space(3))) f32x4_t*)(cb_+8*j_); const f32x4_t b_=*(const __attribute__((address_space(3))) f32x4_t*)(cb_+32+8*j_); \
      P0[4*j_]=nm_-a_[0];P0[4*j_+1]=nm_-a_[1];P0[4*j_+2]=nm_-a_[2];P0[4*j_+3]=nm_-a_[3]; P1[4*j_]=nm_-b_[0];P1[4*j_+1]=nm_-b_[1];P1[4*j_+2]=nm_-b_[2];P1[4*j_+3]=nm_-b_[3]; } }while(0)
  #define CMASK(P0,P1,t) do{int jb_=(t)-(NT-4); if(jb_>=0)cmask(P0,P1,jb_,qrel,hi);}while(0)
  bool resc=false;
  #define START(P0,P1) do{ const float rm=rowmax(P0,P1); resc=false; \
    { const float dl=rm; mhat=fadd_s(mhat,dl); \
      _Pragma("unroll") for(int r=0;r<16;++r){P0[r]=fsub_s(P0[r],dl);P1[r]=fsub_s(P1[r],dl);} \
      } \
    _Pragma("unroll") for(int r=0;r<16;++r)P0[r]=__builtin_amdgcn_exp2f(P0[r]); }while(0)
  #define RESC() do{ if(resc){ asm volatile("s_waitcnt lgkmcnt(0)":::"memory"); \
      _Pragma("unroll") for(int d_=0;d_<2;++d_) _Pragma("unroll") for(int r=0;r<16;++r)o[d_][r]*=wsf[crow(r,hi)]; } }while(0)
  f32x16 pA0,pA1,pB0,pB1;
  int sl_prev=0,sl_cur=0,sl_next=SLOTB;
  #define ROT() do{sl_prev=sl_cur;sl_cur=sl_next;sl_next=(sl_next==(NSLOT-1)*SLOTB)?0:sl_next+SLOTB;}while(0)
  DMA_K(2,2*SLOTB);
  WAIT_BAR(3);
  PREFILL(pA0,pA1,0);qkt(pA0,pA1,Kbase,qr,r32,hi);asm volatile("s_nop 15\n\ts_nop 7":"+v"(pA0),"+v"(pA1));CMASK(pA0,pA1,0);
  START(pA0,pA1);
  _Pragma("unroll") for(int r=0;r<16;++r)pA1[r]=__builtin_amdgcn_exp2f(pA1[r]);
  WAIT_BAR(0);
  DMA_K(3,0);DMA_V(1,SLOTB);
  ROT();
  kload8(kf,kp0+sl_cur);
  WAIT_BAR(2);
  s16x4 vlo[8],vhi[8]; u32x4 pw0,pw1,pw2,pw3;
  #define PKW(P,B) cvtpk_s(P[B],P[B+1])
  #define PAF(k) __builtin_bit_cast(bf16x8,pw##k)
  #define VFR(i) (bf16x8){vlo[i][0],vlo[i][1],vlo[i][2],vlo[i][3],vhi[i][0],vhi[i][1],vhi[i][2],vhi[i][3]}
  #define PIN(x) asm volatile("":"+v"(x))
  #define MX3(a,b,c) __builtin_fmaxf(__builtin_fmaxf((a),(b)),(c))
  #define GAPA(MF,A0,A1,A2,A3,W0,W1,PW) do{ MF; sacc+=A0; sacc+=A1; sacc+=A2; sacc+=A3; PIN(sacc); W0; W1; PIN(PW); SBAR(); }while(0)
  #define EX(v) __builtin_amdgcn_exp2f(v)
  #define GAPB(MF,X,B) do{ MF; X[B]=EX(X[B]); X[B+1]=EX(X[B+1]); X[B+2]=EX(X[B+2]); X[B+3]=EX(X[B+3]); PIN(X); SBAR(); }while(0)
  #define VRD(i) do{ vlo[i]=vtr(vp_+(((i)>>2)*4096+((i)&3)*1024)); vhi[i]=vtr(vp_+(((i)>>2)*4096+((i)&3)*1024+512)); }while(0)
  #define KRD(G,j) do{ if(G){ kload2(kf,kp0+sl_next,j); SBAR(); } }while(0)
  #define STEP(C0,C1,P0,P1,t,GK,GV,GL) do{ SBAR(); \
    const lds_cptr vp_=vp0+sl_prev; \
    PREFILL(C0,C1,t); SBAR(); \
    VRD(0); SBAR(); float sacc=(P0[0]+P0[1]); \
    GAPA(C0=__builtin_amdgcn_mfma_f32_32x32x16_bf16(kf[0],qr[0],C0,0,0,0), P0[2],P0[3],P0[4],P0[5],     pw0[0]=PKW(P0,0), pw0[1]=PKW(P0,2), pw0); \
    VRD(4); SBAR(); GAPA(C1=__builtin_amdgcn_mfma_f32_32x32x16_bf16(kf[1],qr[0],C1,0,0,0), P0[6],P0[7],P0[8],P0[9],     pw0[2]=PKW(P0,4), pw0[3]=PKW(P0,6), pw0); \
    VRD(1); SBAR(); GAPA(C0=__builtin_amdgcn_mfma_f32_32x32x16_bf16(kf[2],qr[1],C0,0,0,0),   P0[10],P0[11],P0[12],P0[13], pw1[0]=PKW(P0,8), pw1[1]=PKW(P0,10), pw1); \
    VRD(5); SBAR(); GAPA(C1=__builtin_amdgcn_mfma_f32_32x32x16_bf16(kf[3],qr[1],C1,0,0,0),   P0[14],P0[15],P1[0],P1[1],   pw1[2]=PKW(P0,12),pw1[3]=PKW(P0,14), pw1); \
    VRD(2); SBAR(); GAPA(C0=__builtin_amdgcn_mfma_f32_32x32x16_bf16(kf[4],qr[2],C0,0,0,0),   P1[2],P1[3],P1[4],P1[5],     pw2[0]=PKW(P1,0), pw2[1]=PKW(P1,2), pw2); \
    VRD(6); SBAR(); GAPA(C1=__builtin_amdgcn_mfma_f32_32x32x16_bf16(kf[5],qr[2],C1,0,0,0),   P1[6],P1[7],P1[8],P1[9],     pw2[2]=PKW(P1,4), pw2[3]=PKW(P1,6), pw2); \
    VRD(3); SBAR(); GAPA(C0=__builtin_amdgcn_mfma_f32_32x32x16_bf16(kf[6],qr[3],C0,0,0,0),   P1[10],P1[11],P1[12],P1[13], pw3[0]=PKW(P1,8), pw3[1]=PKW(P1,10), pw3); \
    VRD(7); SBAR(); GAPA(C1=__builtin_amdgcn_mfma_f32_32x32x16_bf16(kf[7],qr[3],C1,0,0,0),   P1[14],P1[15],0.f,0.f,       pw3[2]=PKW(P1,12),pw3[3]=PKW(P1,14), pw3); \
    l_reg+=sacc; \
    if(GK){DMA_K((t)+3,sl_cur);} if(GV){DMA_V((t)+1,sl_next);} \
    CMASK(C0,C1,t); \
    { float a=MX3(C0[0],C0[1],C1[0]),b=MX3(C0[2],C0[3],C1[1]); a=MX3(a,C1[2],C1[3]); \
      _Pragma("unroll") for(int r=4;r<16;r+=4){a=MX3(a,C0[r],C0[r+1]);b=MX3(b,C0[r+2],C0[r+3]);a=MX3(a,C1[r],C1[r+1]);b=MX3(b,C1[r+2],C1[r+3]);} \
      float rm=__builtin_fmaxf(a,b); { auto rr=__builtin_amdgcn_permlane32_swap(__float_as_uint(rm),__float_as_uint(rm),false,false); rm=__builtin_fmaxf(__uint_as_float(rr[0]),__uint_as_float(rr[1])); } \
      resc=false; \
      if(__builtin_expect(__any(rm>(float)THRL),0)){ const float dl=__builtin_fmaxf(rm,0.f); mhat+=dl; \
        _Pragma("unroll") for(int r=0;r<16;++r){C0[r]-=dl;C1[r]-=dl;} \
        const float f=__builtin_amdgcn_exp2f(-dl); l_reg*=f; if(hi==0)wsf[r32]=f; resc=true; } } \
    SBAR(); \
    GAPB(o[0]=__builtin_amdgcn_mfma_f32_32x32x16_bf16(PAF(0),VFR(0),o[0],0,0,0), C0,0); \
    GAPB(o[1]=__builtin_amdgcn_mfma_f32_32x32x16_bf16(PAF(0),VFR(4),o[1],0,0,0), C0,4); \
    KRD(GL,0); GAPB(o[0]=__builtin_amdgcn_mfma_f32_32x32x16_bf16(PAF(1),VFR(1),o[0],0,0,0), C0,8); \
    KRD(GL,1); GAPB(o[1]=__builtin_amdgcn_mfma_f32_32x32x16_bf16(PAF(1),VFR(5),o[1],0,0,0), C0,12); \
    KRD(GL,2); GAPB(o[0]=__builtin_amdgcn_mfma_f32_32x32x16_bf16(PAF(2),VFR(2),o[0],0,0,0), C1,0); \
    KRD(GL,3); GAPB(o[1]=__builtin_amdgcn_mfma_f32_32x32x16_bf16(PAF(2),VFR(6),o[1],0,0,0), C1,4); \
    GAPB(o[0]=__builtin_amdgcn_mfma_f32_32x32x16_bf16(PAF(3),VFR(3),o[0],0,0,0), C1,8); \
    GAPB(o[1]=__builtin_amdgcn_mfma_f32_32x32x16_bf16(PAF(3),VFR(7),o[1],0,0,0), C1,12); \
    }while(0)
  int t=1;
  #undef CMASK
  #define CMASK(P0,P1,t) do{}while(0)
  for(;t+5<NT;t+=2){
    STEP(pB0,pB1,pA0,pA1,t,true,true,true);     WAIT_BAR(2); RESC(); ROT();
    STEP(pA0,pA1,pB0,pB1,t+1,true,true,true);   WAIT_BAR(2); RESC(); ROT();
  }
  #undef CMASK
  #define CMASK(P0,P1,t) do{int jb_=(t)-(NT-4); if(jb_>=0)cmask(P0,P1,jb_,qrel,hi);}while(0)
  #define ENDW(tt) do{ if((tt)+3<NT){WAIT_BAR(2);} else if((tt)+2<NT){WAIT_BAR(1);} else {WAIT_BAR(0);} }while(0)
  for(;t+1<NT;t+=2){
    STEP(pB0,pB1,pA0,pA1,t,(t+3<NT),(t+1<NT),(t+1<NT));       ENDW(t);   RESC(); ROT();
    STEP(pA0,pA1,pB0,pB1,t+1,(t+4<NT),(t+2<NT),(t+2<NT));     ENDW(t+1); RESC(); ROT();
  }
  STEP(pB0,pB1,pA0,pA1,NT-1,false,false,false); RESC();
  { float sacc=pB0[0]+pB0[1]; _Pragma("unroll") for(int r=2;r<16;++r)sacc+=pB0[r]; _Pragma("unroll") for(int r=0;r<16;++r)sacc+=pB1[r]; l_reg+=sacc;
    pw0=(u32x4){PKW(pB0,0),PKW(pB0,2),PKW(pB0,4),PKW(pB0,6)};pw1=(u32x4){PKW(pB0,8),PKW(pB0,10),PKW(pB0,12),PKW(pB0,14)};pw2=(u32x4){PKW(pB1,0),PKW(pB1,2),PKW(pB1,4),PKW(pB1,6)};pw3=(u32x4){PKW(pB1,8),PKW(pB1,10),PKW(pB1,12),PKW(pB1,14)};
    SBAR(); pv(o,vb0+sl_cur,PAF(0),PAF(1),PAF(2),PAF(3)); }
  #undef PKW
  #undef PAF
  #undef VFR
  #undef PIN
  #undef MX3
  #undef GAPA
  #undef GAPB
  #undef EX
  #undef VRD
  #undef KRD
  #undef STEP
  #undef ENDW
  {auto rr=__builtin_amdgcn_permlane32_swap(__float_as_uint(l_reg),__float_as_uint(l_reg),false,false);l_reg=__uint_as_float(rr[0])+__uint_as_float(rr[1]);}
  if(hi==0)wsf[32+r32]=l_reg;asm volatile("s_waitcnt lgkmcnt(0)":::"memory");
  float rli[16];
  #pragma unroll
  for(int r=0;r<16;++r)rli[r]=__builtin_amdgcn_rcpf(wsf[32+crow(r,hi)]);
  bf16*Ow=Ou+(long)(wid*QBLK)*OP;
  { bf16*stg=(bf16*)(shm+LDS_OST)+wid*2048;
    #pragma unroll
    for(int r=0;r<16;++r){const int orow=crow(r,hi);
      #pragma unroll
      for(int d0=0;d0<2;++d0)stg[orow*64+d0*32+r32]=__float2bfloat16(o[d0][r]*rli[r]);}
    asm volatile("s_waitcnt lgkmcnt(0)":::"memory");
    #pragma unroll
    for(int i=0;i<4;++i){const int row=i*8+(lane>>3),ch=lane&7; const u32x4 v=*(const u32x4*)(stg+row*64+ch*8); if((store_mask>>wid)&1)ATTN_STORE16(Ow+(long)row*OP+ch*8,v);} }
  asm volatile("s_waitcnt lgkmcnt(0)\n\ts_barrier":::"memory");
  #undef DMA_K
  #undef DMA_V
  #undef CMASK
  #undef PREFILL
  #undef START
  #undef RESC
  #undef ROT
}
constexpr int ATTN_LDS_BYTES=LDS_BYTES;
#undef SBAR
#undef WAIT_BAR
}
#ifndef MK_PER_PHASE
#define MK_PER_PHASE 0
#endif
#define LAS __attribute__((address_space(3)))
typedef unsigned short bf16u;
typedef float f32x4 __attribute__((ext_vector_type(4)));
typedef unsigned u32x2 __attribute__((ext_vector_type(2)));
typedef unsigned u32x4 __attribute__((ext_vector_type(4)));
constexpr int DM = 1024, BATCH = 16, SEQ = 2048, DECB = 8, DECS = 32, PAST = 4096;
constexpr int MP = BATCH * SEQ, MS = DECB * DECS, MT = MP + MS;
constexpr int DIN = 2312, DFF = 2816, NGU = 2 * DFF, NMIX = 2304, SKV = 4224;
constexpr float LOG2E = 1.4426950408889634f;
constexpr size_t O_Y = 0, O_YS = 33554432, O_POOLP = 33816576, O_POOLS = 33939456, O_CONVP = 34000896, O_CONVS = 34246656, O_KP = 34369536, O_VP = 67923968, O_FP = 101478400,
                 O_KS = 102002688, O_VS = 102264832, O_FS = 102526976, O_END = 102531072;
constexpr size_t MiB = 1u << 20;
constexpr size_t WS_CTL = 0, CTL_BYTES = 32768;
constexpr int CW_BAR = 1024;
constexpr size_t WS_W = 1 * MiB, WL_STRIDE = 40 * MiB;
constexpr size_t WL_GU1 = 0, WL_D1 = 11 * MiB, WL_IN = 16 * MiB + MiB / 2, WL_OUT = 21 * MiB, WL_GU2 = 23 * MiB, WL_D2 = 34 * MiB;
constexpr size_t WS_XN = 81 * MiB;
constexpr size_t WS_KS = 146 * MiB, KS_STRIDE = 33 * MiB;
constexpr size_t WS_QS = 278 * MiB;
constexpr size_t WS_H = 280 * MiB;
constexpr size_t WS_UP = 280 * MiB, WS_Z = 313 * MiB, WS_QP = 346 * MiB, WS_KP = 378 * MiB, WS_VP = 410 * MiB, WS_END = 458 * MiB;
static_assert(WS_XN + (size_t)MT * 1024 * 2 <= WS_KS && WS_H + (size_t)MT * DFF * 2 <= WS_END && WS_UP + (size_t)MT * 256 * 4 <= WS_Z && WS_Z + (size_t)MT * 256 * 4 <= WS_QP, "ws map");
static_assert(pg8::MIX_UP == WS_UP && pg8::MIX_Z == WS_Z && pg8::MIX_QP == WS_QP && pg8::MIX_KP == WS_KP && pg8::MIX_VP == WS_VP && pg8::MIX_QS == WS_QS && pg8::MIX_KS == WS_KS && pg8::MIX_KSS == KS_STRIDE && pg8::MIX_OKP == O_KP && pg8::MIX_OVP == O_VP && pg8::MIX_OKS == O_KS && pg8::MIX_OVS == O_VS, "epilogue constants");
static_assert(WL_D2 + (size_t)DM * DFF * 2 <= WL_STRIDE && (size_t)8 * SKV * 512 * 2 <= KS_STRIDE, "ws map 2");
constexpr int RING_BYTES = 131072, MISC_OFF = RING_BYTES + 320, LDS_BYTES = 147456;
constexpr int CK2_OFF = 86016;
static_assert(attn_body::ATTN_LDS_BYTES <= CK2_OFF && CK2_OFF + SKV * 4 + 64 <= RING_BYTES, "lds map");

__device__ __forceinline__ unsigned f2bf(float f) { unsigned u = __builtin_bit_cast(unsigned, f); return (u + 0x7fffu + ((u >> 16) & 1u)) >> 16; }
__device__ __forceinline__ unsigned pk2(float lo, float hi) { return f2bf(lo) | (f2bf(hi) << 16); }
__device__ __forceinline__ float wave_sum(float v) {
#pragma unroll
    for (int o = 1; o < 64; o <<= 1) v += __shfl_xor(v, o);
    return v;
}

__device__ __forceinline__ void tr_item(const float* W, int ldw, int sc0, const float* gain, bf16u* WT, int Kdim, int j0, int k0, float* scr, int lane) {
#pragma unroll
    for (int i = 0; i < 8; ++i) { const int kk = 8 * i + (lane >> 3), c4 = 4 * (lane & 7); f32x4 w = *(const f32x4*)(W + (size_t)(k0 + kk) * ldw + sc0 + c4); if (gain) w = w * gain[k0 + kk];
        float* d = scr + kk * 33 + c4; d[0] = w.x; d[1] = w.y; d[2] = w.z; d[3] = w.w; }
    __builtin_amdgcn_wave_barrier(); asm volatile("s_waitcnt lgkmcnt(0)" ::: "memory");
    const int c = lane & 7;
#pragma unroll
    for (int j = 0; j < 4; ++j) { const int n = (lane >> 3) + 8 * j; const float* s = scr + (8 * c) * 33 + n;
        u32x4 o; o.x = pk2(s[0 * 33], s[1 * 33]); o.y = pk2(s[2 * 33], s[3 * 33]); o.z = pk2(s[4 * 33], s[5 * 33]); o.w = pk2(s[6 * 33], s[7 * 33]);
        *(u32x4*)(WT + (size_t)(j0 + n) * Kdim + k0 + 8 * c) = o; }
    __builtin_amdgcn_wave_barrier(); asm volatile("s_waitcnt lgkmcnt(0)" ::: "memory");
}
__device__ __forceinline__ int gu_src(int j0) { const int pn = j0 >> 8, r = j0 & 255; return r < 128 ? 128 * pn + r : DFF + 128 * pn + (r - 128); }
__device__ __forceinline__ int in_src(int j0) {
    const int pn = j0 >> 8, r = j0 & 255;
    if (pn == 0) return r;
    if (pn <= 2) return r < 128 ? 256 + 128 * (pn - 1) + r : 512 + 128 * (pn - 1) + (r - 128);
    const int s = (pn - 3) >> 1, p = (pn - 3) & 1, bj = r >> 7, wc = (r >> 5) & 3;
    return 768 + 512 * s + (4 * p + wc) * 64 + 32 * bj + (r & 31);
}

struct Args { const float* in[25]; float* out; unsigned char* ws; int ph_lo, ph_hi; };
typedef const __attribute__((address_space(4))) Args* ArgsP;
#define ARGS_OPAQUE(a) asm volatile("" : "+s"(a))

template <bool FORGET>
__device__ __forceinline__ void rms_phase(unsigned char* lds, const float* srcP, const float* srcS, float* copy_dst, bf16u* XN,
                                          const float* gain, const float* w_in_l, const float* fb, float* logfP, float* logfS) {
    int tid = threadIdx.x; asm volatile("" : "+v"(tid));
    const int lane = tid & 63, wave = tid >> 6;
    float* WFt = (float*)lds;
    if (FORGET) {
        for (int e = tid; e < 8192; e += 512) { const int k = e >> 3, h = e & 7; WFt[h * 1024 + k] = gain[k] * w_in_l[(size_t)k * DIN + 2304 + h]; }
        __syncthreads();
    }
    const int gw = blockIdx.x * 8 + wave, NGW = gridDim.x * 8;
    for (int m = gw; m < MT; m += NGW) {
        const float* xr = (m < MP) ? srcP + (size_t)m * DM : srcS + (size_t)(m - MP) * DM;
        f32x4 v[4]; float ss = 0.f;
#pragma unroll
        for (int j = 0; j < 4; ++j) { v[j] = ((const f32x4*)xr)[lane + 64 * j]; ss += (v[j].x * v[j].x + v[j].y * v[j].y) + (v[j].z * v[j].z + v[j].w * v[j].w); }
        ss = wave_sum(ss);
        const float rstd = rsqrtf(ss * (1.0f / DM) + 1e-6f);
        if (copy_dst && m >= MP) {
#pragma unroll
            for (int j = 0; j < 4; ++j) ((f32x4*)(copy_dst + (size_t)m * DM))[lane + 64 * j] = v[j];
        }
#pragma unroll
        for (int j = 0; j < 4; ++j) { v[j] = v[j] * rstd; u32x2 w; w.x = pk2(v[j].x, v[j].y); w.y = pk2(v[j].z, v[j].w); ((u32x2*)(XN + (size_t)m * DM))[lane + 64 * j] = w; }
        if (FORGET) {
            float sh[8];
#pragma unroll
            for (int h = 0; h < 8; ++h) { float s = 0.f;
#pragma unroll
                for (int j = 0; j < 4; ++j) { const f32x4 w = *(const f32x4*)(WFt + h * 1024 + 256 * j + 4 * lane); s += (v[j].x * w.x + v[j].y * w.y) + (v[j].z * w.z + v[j].w * w.w); }
                sh[h] = s; }
#define BPX(x, m_) __builtin_bit_cast(float, __builtin_amdgcn_ds_bpermute((lane ^ (m_)) << 2, __builtin_bit_cast(int, (x))))
            float t4[4], u2[2], wv;
            { const bool o = lane & 1;
#pragma unroll
              for (int i = 0; i < 4; ++i) { const float snd = o ? sh[i] : sh[4 + i], kp = o ? sh[4 + i] : sh[i]; t4[i] = kp + BPX(snd, 1); } }
            { const bool o = lane & 2;
#pragma unroll
              for (int i = 0; i < 2; ++i) { const float snd = o ? t4[i] : t4[2 + i], kp = o ? t4[2 + i] : t4[i]; u2[i] = kp + BPX(snd, 2); } }
            { const bool o = lane & 4; const float snd = o ? u2[0] : u2[1], kp = o ? u2[1] : u2[0]; wv = kp + BPX(snd, 4); }
            wv += BPX(wv, 8); wv += BPX(wv, 16); wv += BPX(wv, 32);
#undef BPX
            const int hh = ((lane & 1) << 2) | (lane & 2) | ((lane >> 2) & 1);
            if (lane < 8) { const float x = wv + fb[hh]; const float lf = (x < 0.f) ? x - log1pf(expf(x)) : -log1pf(expf(-x));
                float* dst = (m < MP) ? logfP + (size_t)m * 8 : logfS + (size_t)(m - MP) * 8; dst[hh] = lf; }
        }
    }
}

constexpr int I_GU = 16 * 176, I_D = 44 * 32, I_IN = 16 * 72, I_OUT = 12 * 32, I_L = 2 * I_GU + 2 * I_D + I_IN + I_OUT;
constexpr int I_W = 2 * I_L, I_C = 2 * 2 * 8 * 528, I_P = 128;
__device__ __forceinline__ void conv_item(ArgsP a, int it, float* scr, int lane) {
    if (it < I_W) {
            const int l = it / I_L; int r = it % I_L; unsigned char* wl = a->ws + WS_W + (size_t)l * WL_STRIDE;
            if (r < I_GU) { const int kb = r / 176, j0 = 32 * (r % 176); tr_item(a->in[8] + (size_t)l * DM * NGU, NGU, gu_src(j0), a->in[7] + l * DM, (bf16u*)(wl + WL_GU1), DM, j0, 64 * kb, scr, lane); return; } r -= I_GU;
            if (r < I_D) { const int kb = r / 32, j0 = 32 * (r % 32); tr_item(a->in[9] + (size_t)l * DFF * DM, DM, j0, nullptr, (bf16u*)(wl + WL_D1), DFF, j0, 64 * kb, scr, lane); return; } r -= I_D;
            if (r < I_IN) { const int kb = r / 72, j0 = 32 * (r % 72); tr_item(a->in[11] + (size_t)l * DM * DIN, DIN, in_src(j0), a->in[10] + l * DM, (bf16u*)(wl + WL_IN), DM, j0, 64 * kb, scr, lane); return; } r -= I_IN;
            if (r < I_OUT) { const int kb = 4 + r / 32, j0 = 32 * (r % 32); tr_item(a->in[12] + (size_t)l * DM * DM, DM, j0, nullptr, (bf16u*)(wl + WL_OUT), DM, j0, 64 * kb, scr, lane); return; } r -= I_OUT;
            if (r < I_GU) { const int kb = r / 176, j0 = 32 * (r % 176); tr_item(a->in[23] + (size_t)l * DM * NGU, NGU, gu_src(j0), a->in[22] + l * DM, (bf16u*)(wl + WL_GU2), DM, j0, 64 * kb, scr, lane); return; } r -= I_GU;
            { const int kb = r / 32, j0 = 32 * (r % 32); tr_item(a->in[24] + (size_t)l * DFF * DM, DM, j0, nullptr, (bf16u*)(wl + WL_D2), DFF, j0, 64 * kb, scr, lane); }
    } else {
            int r = it - I_W; const int l = r / 8448; r %= 8448; const int kv = r / 4224; r %= 4224; const int b = r / 528, r8 = r % 528;
            const float* src = a->in[4 + kv] + ((size_t)(l * 8 + b) * PAST) * 512;
            bf16u* dst = (bf16u*)(a->ws + WS_KS + (size_t)(2 * l + kv) * KS_STRIDE) + (size_t)b * SKV * 512;
            const int row0 = r8 * 8;
            if (row0 >= 4096 && row0 < 4128) return;
#pragma unroll
            for (int i = 0; i < 8; ++i) { const int row = row0 + i;
#pragma unroll
                for (int q = 0; q < 2; ++q) { f32x4 v = (f32x4){0.f, 0.f, 0.f, 0.f}; if (row0 < 4096) v = ((const f32x4*)(src + (size_t)row * 512))[lane + 64 * q];
                    u32x2 w; w.x = pk2(v.x, v.y); w.y = pk2(v.z, v.w); ((u32x2*)(dst + (size_t)row * 512))[lane + 64 * q] = w; } }
    }
}
__device__ __forceinline__ void fold_item(ArgsP a, int it, int lane) {
            const int r = it, l = r >> 6, g = (r >> 4) & 3, nb = r & 15, n = 64 * nb + lane;
            const float* wo = a->in[12] + (size_t)l * DM * DM; const float* ps = a->in[14] + l * 256 + g * 64; const float* pw = a->in[13] + (size_t)(l * 4 + g) * 4096;
            bf16u* wt = (bf16u*)(a->ws + WS_W + (size_t)l * WL_STRIDE + WL_OUT);
            float wreg[64];
#pragma unroll
            for (int dd = 0; dd < 64; ++dd) wreg[dd] = ps[dd] * wo[(size_t)(g * 64 + dd) * DM + n];
            for (int c = 0; c < 64; c += 2) { float a0 = 0.f, a1 = 0.f;
#pragma unroll
                for (int dd = 0; dd < 64; ++dd) { a0 += pw[c * 64 + dd] * wreg[dd]; a1 += pw[(c + 1) * 64 + dd] * wreg[dd]; }
                *(unsigned*)(wt + (size_t)n * DM + g * 64 + c) = pk2(a0, a1); }
}
__device__ __forceinline__ void filler(unsigned char* lds, ArgsP a, int first_wg, int lo0, int hi0, int lo1, int hi1) {
    ARGS_OPAQUE(a);
    int tid = threadIdx.x; asm volatile("" : "+v"(tid));
    if ((int)gridDim.x <= first_wg) first_wg = 0;
    if ((int)blockIdx.x < first_wg) return;
    const int lane = tid & 63, wave = tid >> 6; float* scr = (float*)(lds + wave * 16384);
    const int fw = ((int)blockIdx.x - first_wg) * 8 + wave, nfw = ((int)gridDim.x - first_wg) * 8, n0 = hi0 - lo0, n1 = hi1 - lo1;
    for (int j = fw; j < n0 + n1; j += nfw) conv_item(a, j < n0 ? lo0 + j : lo1 + (j - n0), scr, lane);
}
__device__ __forceinline__ void prologue(unsigned char* lds, ArgsP a) {
    int tid = threadIdx.x; asm volatile("" : "+v"(tid));
    const int lane = tid & 63, wave = tid >> 6;
    float* scr = (float*)(lds + wave * 16384);
    const int gw = blockIdx.x * 8 + wave, NGW = gridDim.x * 8;
    for (int j = gw; j < I_P + I_GU; j += NGW) { if (j < I_P) fold_item(a, j, lane); else conv_item(a, j - I_P, scr, lane); }
    rms_phase<false>(lds, a->in[0], a->in[1], a->out, (bf16u*)(a->ws + WS_XN), nullptr, nullptr, nullptr, nullptr, nullptr);
}

__device__ __forceinline__ void scan_ck2(float* ck2, float* wsum, int n, const float* src0, int n0, const float* src1, int n1) {
    int tid = threadIdx.x; asm volatile("" : "+v"(tid));
    const int lane = tid & 63, wave = tid >> 6;
    const int per = (n + 511) >> 9, base = tid * per;
    float v[9]; float loc = 0.f;
#pragma unroll
    for (int k = 0; k < 9; ++k) { const int i = base + k; v[k] = 0.f; if (k < per) { if (i < n0) v[k] = src0[(size_t)i * 8]; else if (i < n0 + n1) v[k] = src1[(size_t)(i - n0) * 8]; } }
#pragma unroll
    for (int k = 0; k < 9; ++k) loc += v[k];
    float inc = loc;
#pragma unroll
    for (int o = 1; o < 64; o <<= 1) { const float t = __builtin_bit_cast(float, __builtin_amdgcn_ds_bpermute(((lane - o) & 63) << 2, __builtin_bit_cast(int, inc))); if (lane >= o) inc += t; }
    if (lane == 63) wsum[wave] = inc;
    __syncthreads();
    float run = inc - loc;
    for (int w = 0; w < wave; ++w) run += wsum[w];
#pragma unroll
    for (int k = 0; k < 9; ++k) { if (k < per) { const int i = base + k; run += v[k]; if (i < n) ck2[i] = run * LOG2E; } }
    __syncthreads();
}

__device__ __forceinline__ void poolconv_unit(unsigned char* lds, ArgsP a, int l, int tt) {
    int tid = threadIdx.x; asm volatile("" : "+v"(tid));
    const int lane = tid & 63, wave = tid >> 6;
    const bool samp = tt >= 1024; const int b = samp ? tt - 1024 : tt >> 6, t0 = samp ? 0 : (tt & 63) * 32; const size_t row0 = (size_t)tt * 32;
    const float* UP = (const float*)(a->ws + WS_UP); const float* Z = (const float*)(a->ws + WS_Z); bf16u* Y = (bf16u*)(a->ws + WS_XN);
    float* pb = (float*)lds; float* yb = (float*)(lds + 65536);
    const bool last = samp || t0 == SEQ - 32;
    f32x4 pv[6], zv[8];
#pragma unroll
    for (int q = 0; q < 6; ++q) { const int e = tid + 512 * q, j = e >> 6, c4 = (e & 63) * 4, tm = t0 - 15 + j; pv[q] = (f32x4){0.f, 0.f, 0.f, 0.f};
        if (e < 47 * 64) { if (tm >= 0) pv[q] = *(const f32x4*)(UP + (row0 + j - 15) * 256 + c4); else if (samp) pv[q] = *(const f32x4*)(a->in[2] + ((size_t)(l * 8 + b) * 15 + j) * 256 + c4); } }
#pragma unroll
    for (int q = 0; q < 8; ++q) { const int e = tid + 512 * q, i = e >> 6, c4 = (e & 63) * 4, tm = t0 - 30 + i; zv[q] = (f32x4){0.f, 0.f, 0.f, 0.f};
        if (e < 62 * 64) { if (tm >= 0) zv[q] = *(const f32x4*)(Z + (row0 + i - 30) * 256 + c4); else if (samp) zv[q] = *(const f32x4*)(a->in[3] + ((size_t)(l * 8 + b) * 30 + i) * 256 + c4); } }
    const int c = tid & 255, half = tid >> 8;
    float cw[31];
#pragma unroll
    for (int j = 0; j < 31; ++j) cw[j] = a->in[15][(size_t)(l * 31 + j) * 256 + c];
    const float cb = a->in[16][l * 256 + c];
#pragma unroll
    for (int q = 0; q < 6; ++q) { const int e = tid + 512 * q; if (e < 47 * 64) *(f32x4*)(pb + (e >> 6) * 256 + (e & 63) * 4) = pv[q]; }
    __syncthreads();
    { const int w = 2 << (c >> 6);
      const int r0p = half * 16; float xr[31];
#pragma unroll
      for (int i = 0; i < 31; ++i) xr[i] = pb[(r0p + i) * 256 + c];
#pragma unroll
      for (int t = 0; t < 16; ++t) { float s = 0.f;
#pragma unroll
          for (int k = 0; k < 16; ++k) { if (k < w) s += xr[t + 15 - k]; }
          const int tl = r0p + t, cnt = samp ? w : min(t0 + tl + 1, w); const float d = s * __builtin_amdgcn_rcpf((float)cnt) - xr[t + 15];
          Y[(row0 + tl) * 1024 + c] = (bf16u)f2bf(d); }
      if (last) { float* dst = samp ? a->out + O_POOLS + (size_t)(l * 8 + b) * 15 * 256 : a->out + O_POOLP + (size_t)(l * 16 + b) * 15 * 256;
          for (int e = tid; e < 15 * 256; e += 512) dst[e] = pb[32 * 256 + e]; } }
    __syncthreads();
    float* zb = pb;
#pragma unroll
    for (int q = 0; q < 8; ++q) { const int e = tid + 512 * q; if (e < 62 * 64) *(f32x4*)(zb + (e >> 6) * 256 + (e & 63) * 4) = zv[q]; }
    __syncthreads();
    { const int r0 = half * 16; float acc[16];
#pragma unroll
      for (int t = 0; t < 16; ++t) acc[t] = cb;
#pragma unroll
      for (int i = 0; i < 46; ++i) { const float zq = zb[(r0 + i) * 256 + c];
#pragma unroll
          for (int t = 0; t < 16; ++t) { if (i - t >= 0 && i - t < 31) acc[t] += zq * cw[i - t]; } }
#pragma unroll
      for (int t = 0; t < 16; ++t) yb[(r0 + t) * 256 + c] = acc[t];
      if (last) { float* dst = samp ? a->out + O_CONVS + (size_t)(l * 8 + b) * 30 * 256 : a->out + O_CONVP + (size_t)(l * 16 + b) * 30 * 256;
          for (int e = tid; e < 30 * 256; e += 512) dst[e] = zb[32 * 256 + e]; } }
    __syncthreads();
    { const f32x4 g = *(const f32x4*)(a->in[17] + l * 256 + lane * 4), be = *(const f32x4*)(a->in[18] + l * 256 + lane * 4);
      f32x4 vq[4]; float s1[4], s2[4];
#pragma unroll
      for (int q = 0; q < 4; ++q) { vq[q] = *(const f32x4*)(yb + (wave * 4 + q) * 256 + lane * 4); s1[q] = (vq[q].x + vq[q].y) + (vq[q].z + vq[q].w); }
#pragma unroll
      for (int q = 0; q < 4; ++q) s1[q] = wave_sum(s1[q]) * (1.0f / 256.0f);
#pragma unroll
      for (int q = 0; q < 4; ++q) { vq[q] = vq[q] - s1[q]; s2[q] = (vq[q].x * vq[q].x + vq[q].y * vq[q].y) + (vq[q].z * vq[q].z + vq[q].w * vq[q].w); }
#pragma unroll
      for (int q = 0; q < 4; ++q) s2[q] = wave_sum(s2[q]) * (1.0f / 256.0f);
#pragma unroll
      for (int q = 0; q < 4; ++q) { const int row = wave * 4 + q; const float rs = rsqrtf(s2[q] + 1e-6f);
          f32x4 y = vq[q] * rs * g + be; y.x = y.x * pg8::sigmoid_f(y.x); y.y = y.y * pg8::sigmoid_f(y.y); y.z = y.z * pg8::sigmoid_f(y.z); y.w = y.w * pg8::sigmoid_f(y.w);
          u32x2 w; w.x = pk2(y.x, y.y); w.y = pk2(y.z, y.w); *(u32x2*)(Y + (row0 + row) * 1024 + 256 + lane * 4) = w; } }
    __syncthreads();
}

constexpr int N_ATT_S = 64, N_ATT_P = 1024, N_PC = 1032, N_MIX_UNITS = N_ATT_S + N_ATT_P + N_PC;
__device__ __forceinline__ void mix_phase(unsigned char* lds, ArgsP a, int l) {
    ARGS_OPAQUE(a);
    const int tid = threadIdx.x;
    volatile unsigned* MISC = (volatile unsigned*)(lds + MISC_OFF);
    unsigned* ctr = (unsigned*)(a->ws + WS_CTL) + 64 * (1 + l);
    float* ck2 = (float*)(lds + CK2_OFF); float* wsum = (float*)(lds + CK2_OFF + SKV * 4);
    bf16u* Y = (bf16u*)(a->ws + WS_XN);
    const float* lfP = a->out + O_FP + (size_t)l * MP * 8; const float* lfS = a->out + O_FS + (size_t)l * MS * 8;
    if (tid == 0) MISC[0] = atomicAdd(ctr, 1u);
    for (;;) {
        __syncthreads();
        const int idx = __builtin_amdgcn_readfirstlane((int)MISC[0]);
        if (idx >= N_MIX_UNITS) break;
        const int uix = idx < N_ATT_S ? idx : (idx < N_ATT_S + N_PC ? idx + N_ATT_P : idx - N_PC);
        unsigned nxt = 0u; if (tid == 0) nxt = atomicAdd(ctr, 1u);
        __syncthreads();
        if (uix < N_ATT_S + N_ATT_P) {
            const attn_body::bf16 *Q, *K, *V; attn_body::bf16* O; int NT, smask;
            if (uix < N_ATT_S) {
                const int b = uix >> 3, h = uix & 7;
                scan_ck2(ck2, wsum, SKV, a->in[6] + ((size_t)(l * 8 + b) * PAST) * 8 + h, PAST, lfS + (size_t)b * DECS * 8 + h, DECS);
                Q = (const attn_body::bf16*)(a->ws + WS_QS) + (size_t)b * 256 * 512 + h * 64;
                K = (const attn_body::bf16*)(a->ws + WS_KS + (size_t)(2 * l) * KS_STRIDE) + (size_t)b * SKV * 512 + h * 64;
                V = (const attn_body::bf16*)(a->ws + WS_KS + (size_t)(2 * l + 1) * KS_STRIDE) + (size_t)b * SKV * 512 + h * 64;
                O = (attn_body::bf16*)Y + ((size_t)MP + b * DECS - 128) * 1024 + 512 + h * 64;
                NT = SKV / 64; smask = 1 << 4;
            } else {
                const int j = uix - N_ATT_S, qb = 7 - (j >> 7), bh = j & 127, b = bh >> 3, h = bh & 7;
                scan_ck2(ck2, wsum, 256 * (qb + 1), lfP + (size_t)b * SEQ * 8 + h, 256 * (qb + 1), nullptr, 0);
                const size_t r0 = (size_t)b * SEQ;
                Q = (const attn_body::bf16*)(a->ws + WS_QP) + (r0 + qb * 256) * 512 + h * 64;
                K = (const attn_body::bf16*)(a->ws + WS_KP) + r0 * 512 + h * 64;
                V = (const attn_body::bf16*)(a->ws + WS_VP) + r0 * 512 + h * 64;
                O = (attn_body::bf16*)Y + (r0 + qb * 256) * 1024 + 512 + h * 64;
                NT = 4 * (qb + 1); smask = 0xff;
            }
#ifndef DIS_ATT
            attn_body::attn_unit<8>(Q, K, V, O, NT, smask, (attn_body::lds_cfptr)ck2, (char*)lds);
#endif
        } else {
#ifndef DIS_PC
            poolconv_unit(lds, a, l, uix - N_ATT_S - N_ATT_P);
#endif
        }
        if (tid == 0) MISC[0] = nxt;
    }
}

#define XB_TMO      128
#define XB_XCNT(j)  (256  + 64 * (j))
#define XB_XSUB(j)  (1280 + 64 * (j))
#define XB_XGEN(j)  (2304 + 64 * (j))
#define XB_TOP      3328
#define XB_TOPGEN   3392
#define XCD_BAR_WORDS 3456
#define XB_SPIN_CAP (1u << 18)

__device__ __forceinline__ unsigned xb_ld(unsigned* p)              { return __hip_atomic_load(p, __ATOMIC_RELAXED, __HIP_MEMORY_SCOPE_AGENT); }
__device__ __forceinline__ unsigned xb_add(unsigned* p, unsigned v) { return __hip_atomic_fetch_add(p, v, __ATOMIC_RELAXED, __HIP_MEMORY_SCOPE_AGENT); }
__device__ __forceinline__ unsigned xb_xcc_id() { return (unsigned)__builtin_amdgcn_s_getreg((3 << 11) | 20) & 0xFu; }
#define XB_SPIN(cond, bar) do { unsigned _sp = 0; while (cond) { __builtin_amdgcn_s_sleep(1); \
    if ((++_sp & 255u) == 0u) { if (xb_ld(&(bar)[XB_TMO])) break; if (_sp > XB_SPIN_CAP) { atomicAdd(&(bar)[XB_TMO], 1u); break; } } } } while (0)

struct XcdBarrier {
    unsigned* bar; unsigned x;
    volatile LAS unsigned* st;
};

__device__ __forceinline__ XcdBarrier xcd_barrier_post(unsigned* bar, volatile LAS unsigned* st) {
    XcdBarrier b; b.bar = bar; b.x = xb_xcc_id(); b.st = st;
    if (threadIdx.x == 0) (void)xb_add(&bar[XB_XCNT(b.x)], 1u);
    return b;
}
__device__ __forceinline__ void xcd_barrier_complete(unsigned* bar, unsigned x, unsigned& nloc, unsigned& nx) {
    const unsigned G = gridDim.x * gridDim.y * gridDim.z;
    unsigned sum, cnt, mine, sp = 0u;
    for (;;) {
        sum = 0u; cnt = 0u; mine = 0u;
#pragma unroll
        for (unsigned j = 0; j < 16; ++j) { const unsigned c = xb_ld(&bar[XB_XCNT(j)]); sum += c; cnt += (c > 0u) ? 1u : 0u; mine = (j == x) ? c : mine; }
        if (sum == G) break;
        __builtin_amdgcn_s_sleep(1);
        if ((++sp & 255u) == 0u) { if (xb_ld(&bar[XB_TMO])) break; if (sp > XB_SPIN_CAP) { atomicAdd(&bar[XB_TMO], 1u); break; } }
    }
    nloc = mine > 0u ? mine : 1u; nx = cnt > 0u ? cnt : 1u;
}

__device__ __forceinline__ void xcd_barrier(const XcdBarrier& b) {
    asm volatile("s_waitcnt vmcnt(0)" ::: "memory");
    __syncthreads();
    if (threadIdx.x == 0) {
        unsigned* bar = b.bar;
        __builtin_amdgcn_s_waitcnt(0);
        unsigned nloc = b.st[0], nx = b.st[1];
        if (nloc == 0u) { xcd_barrier_complete(bar, b.x, nloc, nx); b.st[0] = nloc; b.st[1] = nx; }
        const unsigned old = xb_add(&bar[XB_XSUB(b.x)], 1u);
        const unsigned gen = old / nloc;
        if (old + 1u == (gen + 1u) * nloc) {
            __builtin_amdgcn_fence(__ATOMIC_RELEASE, "agent");
            asm volatile("s_waitcnt vmcnt(0)" ::: "memory");
            const unsigned og = xb_add(&bar[XB_TOP], 1u);
            const unsigned tg = og / nx;
            if (og + 1u == (tg + 1u) * nx) xb_add(&bar[XB_TOPGEN], 1u);
            else XB_SPIN(xb_ld(&bar[XB_TOPGEN]) == tg, bar);
            __builtin_amdgcn_fence(__ATOMIC_ACQUIRE, "agent");
            xb_add(&bar[XB_XGEN(b.x)], 1u);
            asm volatile("s_waitcnt vmcnt(0)" ::: "memory");
        } else {
            XB_SPIN(xb_ld(&bar[XB_XGEN(b.x)]) == gen, bar);
            __builtin_amdgcn_fence(__ATOMIC_ACQUIRE, "agent");
            asm volatile("s_waitcnt vmcnt(0)" ::: "memory");
        }
    }
    __syncthreads();
}

template <class Epi> __device__ __forceinline__ void run_gemm(unsigned char* lds, const bf16u* A, const bf16u* Bt, int M, int N, int K, const Epi& E) {
    pg8::Gemm g{A, Bt, M, N, K, K}; pg8::StaticOrder S; S.init(M, N, (int)gridDim.x, (int)blockIdx.x);
    pg8::gemm_phase<Epi, pg8::StaticOrder, true, true>((LAS unsigned char*)lds, g, S, E);
}
__device__ __forceinline__ void run_gemm_resid(unsigned char* lds, const bf16u* A, const bf16u* Bt, int K, int nk, const float* Bp, float* X, float alpha) {
    { pg8::EpiResid E{Bp, X, DM, alpha}; run_gemm(lds, A, Bt, MP, DM, K, E); }
    { pg8::Gemm g{A, Bt, MT, DM, K / nk, K}; pg8::SplitOrder S{DM / 256, nk, K / nk, MP / 256, (int)blockIdx.x}; pg8::EpiResidAtomic E{X, DM, alpha};
      pg8::gemm_phase<pg8::EpiResidAtomic, pg8::SplitOrder, false, true>((LAS unsigned char*)lds, g, S, E); }
}

__global__ void __launch_bounds__(512, 2) mk_fwd(Args kargs) {
    extern __shared__ __attribute__((aligned(16))) unsigned char lds[];
    cg::grid_group grid = cg::this_grid();
    ArgsP a = (ArgsP)__builtin_amdgcn_kernarg_segment_ptr();
    volatile LAS unsigned* MISCW = (volatile LAS unsigned*)((LAS unsigned char*)lds + MISC_OFF);
    if (threadIdx.x < 16) MISCW[threadIdx.x] = 0u;
    __syncthreads();
    XcdBarrier bar = xcd_barrier_post((unsigned*)(a->ws + WS_CTL) + CW_BAR, MISCW + 8);
    const int lo = a->ph_lo, hi = a->ph_hi; int ph = 0;
    if (lo < 0) grid.sync();
#define PH_IN (ph >= lo && ph < hi)
#define PH_END do { if (ph >= lo && ph + 1 < hi) { if (!MK_PER_PHASE) xcd_barrier(bar); } ++ph; } while (0)
    bf16u* XN = (bf16u*)(a->ws + WS_XN); bf16u* H = (bf16u*)(a->ws + WS_H);
#ifndef DIS_PRO
    if (PH_IN) prologue(lds, a);
#endif
    PH_END;
    for (int hl = 0; hl < 4; ++hl) {
        const int l = hl >> 1, f = hl & 1;
        ARGS_OPAQUE(a);
        unsigned char* wl = a->ws + WS_W + (size_t)l * WL_STRIDE;
#ifndef DIS_G1
        if (PH_IN) { pg8::EpiSwiglu E{H, DFF}; run_gemm(lds, XN, (const bf16u*)(wl + (f ? WL_GU2 : WL_GU1)), MT, NGU, DM, E);
            if (hl == 0) filler(lds, a, 22, I_GU, I_GU + I_D + I_IN, I_W, I_W + I_C / 2);
            else if (hl == 1) filler(lds, a, 22, I_L, I_L + I_GU + I_D + I_IN, 0, 0);
            else if (hl == 2) filler(lds, a, 22, I_W + I_C / 2, I_W + I_C, 0, 0); }
#endif
        PH_END;
#ifndef DIS_G2
        if (PH_IN) run_gemm_resid(lds, H, (const bf16u*)(wl + (f ? WL_D2 : WL_D1)), DFF, 11, hl == 0 ? a->in[0] : a->out, a->out, 0.5f);
#endif
        PH_END;
        if (f == 0) {
#ifndef DIS_RMS
            if (PH_IN) rms_phase<true>(lds, a->out, a->out + (size_t)MP * DM, nullptr, XN, a->in[10] + l * DM, a->in[11] + (size_t)l * DM * DIN, a->in[21] + l * 8,
                                       a->out + O_FP + (size_t)l * MP * 8, a->out + O_FS + (size_t)l * MS * 8);
#endif
            PH_END;
#ifndef DIS_G3
            if (PH_IN) {
                pg8::EpiMixIn E{a->ws, a->out, a->in[19] + l * 64, a->in[20] + l * 64, l, attn_body::C2};
                run_gemm(lds, XN, (const bf16u*)(wl + WL_IN), MT, NMIX, DM, E);
                filler(lds, a, 137, l * I_L + I_GU + I_D + I_IN, (l + 1) * I_L, 0, 0);
            }
#endif
            PH_END;
#ifndef DIS_MIX
            if (PH_IN) mix_phase(lds, a, l);
#endif
            PH_END;
#ifndef DIS_G4
            if (PH_IN) run_gemm_resid(lds, XN, (const bf16u*)(wl + WL_OUT), DM, 4, a->out, a->out, 1.0f);
#endif
            PH_END;
            if (PH_IN) rms_phase<false>(lds, a->out, a->out + (size_t)MP * DM, nullptr, XN, nullptr, nullptr, nullptr, nullptr, nullptr);
            PH_END;
        } else if (l == 0) {
            if (PH_IN) rms_phase<false>(lds, a->out, a->out + (size_t)MP * DM, nullptr, XN, nullptr, nullptr, nullptr, nullptr, nullptr);
            PH_END;
        }
    }
#undef PH_IN
#undef PH_END
}
constexpr int N_PHASES = 1 + 2 * (2 + 5 + 2) + 1;

extern "C" void kernel_launch(void* const* d_in, const int* in_sizes, int n_in, void* d_out, int out_size, void* d_ws, size_t ws_size, hipStream_t stream) {
    static int grid = 0;
    if (grid == 0) {
        if (n_in != 25 || out_size != (int)O_END || ws_size < WS_END) { fprintf(stderr, "kernel_launch: unexpected shapes: n_in %d out %d ws %zu (need %zu)\n", n_in, out_size, ws_size, (size_t)WS_END); grid = -1; return; }
        int dev = 0, cus = 0, per_cu = 0;
        if (hipGetDevice(&dev) != hipSuccess || hipDeviceGetAttribute(&cus, hipDeviceAttributeMultiprocessorCount, dev) != hipSuccess) { grid = -1; return; }
        if (hipFuncSetAttribute((const void*)mk_fwd, hipFuncAttributeMaxDynamicSharedMemorySize, LDS_BYTES) != hipSuccess) { fprintf(stderr, "kernel_launch: hipFuncSetAttribute failed\n"); grid = -1; return; }
        if (hipOccupancyMaxActiveBlocksPerMultiprocessor(&per_cu, (const void*)mk_fwd, 512, LDS_BYTES) != hipSuccess || per_cu < 1) { fprintf(stderr, "kernel_launch: occupancy query says %d\n", per_cu); per_cu = 1; }
        (void)hipGetLastError();
        grid = cus;
        fprintf(stderr, "kernel_launch: grid %d (occupancy %d per CU)\n", grid, per_cu);
    }
    if (grid < 0) return;
    (void)hipMemsetAsync((char*)d_ws + WS_CTL, 0, CTL_BYTES, stream);
    Args a{};
    for (int i = 0; i < 25; ++i) a.in[i] = (const float*)d_in[i];
    a.out = (float*)d_out; a.ws = (unsigned char*)d_ws;
#if MK_PER_PHASE
    for (int p = 0; p < N_PHASES; ++p) { a.ph_lo = p; a.ph_hi = p + 1; hipLaunchKernelGGL(mk_fwd, dim3(grid), dim3(512), LDS_BYTES, stream, a); }
#else
    a.ph_lo = 0; a.ph_hi = N_PHASES;
    void* args[] = {&a};
    const hipError_t e = hipLaunchCooperativeKernel((const void*)mk_fwd, dim3(grid), dim3(512), args, LDS_BYTES, stream);
    if (e != hipSuccess) fprintf(stderr, "kernel_launch: cooperative launch failed: %s (grid %d)\n", hipGetErrorString(e), grid);
#endif
}
```

```cpp
#include <hip/hip_runtime.h>
#include <hip/hip_bf16.h>
#include <hip/hip_cooperative_groups.h>
#include <cstdio>
#include <cstdint>
#include <cmath>
namespace cg = cooperative_groups;
namespace pg8 {
#define PG8_LAS __attribute__((address_space(3)))
typedef unsigned short bf16_t;
typedef short bf16x8 __attribute__((ext_vector_type(8)));
typedef float f32x4 __attribute__((ext_vector_type(4)));
typedef unsigned u32x4 __attribute__((ext_vector_type(4)));
constexpr int BM = 256, BK = 64, HALF = 128, HTB = HALF * BK * 2  , STAGE_BYTES = 8 * HTB, NXCD = 8, WGM = 8;

__host__ __device__ __forceinline__ int lds_byte(int r, int c) { const int st = (r >> 4) * 2 + (c >> 5), rr = r & 15, cc = c & 31, ob = rr * 64 + cc * 2; return st * 1024 + (ob ^ (((ob >> 9) & 1) << 5)); }
__host__ __device__ __forceinline__ void stage_rc(int b, int& R, int& C) { const int st = b / 1024, sb = b % 1024, swz = sb ^ (((sb >> 9) & 1) << 5); R = (st >> 1) * 16 + swz / 64; C = (st & 1) * 32 + (swz % 64) / 2; }
__host__ __device__ __forceinline__ int perm32(int rho) { const int n = rho >> 4, i = rho & 15; return 8 * (i >> 2) + 4 * n + (i & 3); }

struct Unit { int pm, pn, ko; };
struct Gemm { const bf16_t* A; const bf16_t* Bt; int M, N, K, ld; };

struct StaticOrder {
    int nM, nN, nwg, G, c;
    __host__ __device__ void init(int M, int N, int G_, int c_) { nM = M / BM; nN = N / BM; nwg = nM * nN; G = G_; c = c_; }
    __host__ __device__ bool next(int i, Unit& u) const {
        const long L = (long)i * G + c; if (L >= nwg) return false;
        int wgid = (int)L; { const int q = nwg / NXCD, r = nwg % NXCD, xcd = wgid % NXCD, off = wgid / NXCD; wgid = (xcd < r ? xcd * (q + 1) : r * (q + 1) + (xcd - r) * q) + off; }
        const int nig = WGM * nN, gid = wgid / nig, fm = gid * WGM, gsz = (nM - fm) < WGM ? (nM - fm) : WGM;
        u.pm = fm + ((wgid % nig) % gsz); u.pn = (wgid % nig) / gsz; u.ko = 0; return true;
    }
    __device__ __forceinline__ void a_ready(const Unit&) const {}
    __device__ __forceinline__ void done(const Unit&) const {}
};

__device__ __forceinline__ unsigned cvt_pk_bf16(float lo, float hi) { unsigned r; asm volatile("v_cvt_pk_bf16_f32 %0, %1, %2" : "=v"(r) : "v"(lo), "v"(hi)); return r; }
typedef float f32x2 __attribute__((ext_vector_type(2)));
template <class Epi, class Sched, bool ALIGN_EPI = false, bool SP2 = false>
__device__ __forceinline__ void gemm_phase(PG8_LAS unsigned char* lds, const Gemm g, const Sched& S, const Epi& E) {
    int tid = threadIdx.x; asm volatile("" : "+v"(tid));
    const int wid = __builtin_amdgcn_readfirstlane(tid >> 6), lane = tid & 63, wr = wid >> 2, wc = wid & 3, fr = lane & 15, fq = lane >> 4;
    const int K = g.K, nt = K / BK;
    unsigned voffA[2], voffB[2];
#pragma unroll
    for (int i = 0; i < 2; ++i) { int R, C; stage_rc(tid * 16 + i * 8192, R, C); const int Rb = Epi::PERM ? ((R & ~31) + perm32(R & 31)) : R;
        voffA[i] = (unsigned)(R * g.ld + C) * 2u; voffB[i] = (unsigned)(Rb * g.ld + C) * 2u; }
    const size_t kstep = (size_t)(BK * 2);
    const size_t hstep = (size_t)HALF * g.ld * 2;
    const size_t tstep = 2 * hstep;
    const unsigned ldsw = (unsigned)wid * 1024u;
    const int aoff = lds_byte(wr * 64 + fr, fq * 8), boff = lds_byte(wc * 32 + fr, fq * 8);
#define PG8_SA(b, h) (((b) * 2 + (h)) * HTB)
#define PG8_SB(b, h) ((4 + (b) * 2 + (h)) * HTB)
#define PG8_STAGE(bufoff, gbase, voff) do { _Pragma("unroll") for (int _i = 0; _i < 2; ++_i) \
        __builtin_amdgcn_global_load_lds((const unsigned*)((const char*)(gbase) + (voff)[_i]), (PG8_LAS unsigned*)(lds + (bufoff) + ldsw + _i * 8192), 16, 0, 0); } while (0)
#define PG8_LDA(dst, b, h) do { _Pragma("unroll") for (int m = 0; m < 4; ++m) _Pragma("unroll") for (int k = 0; k < 2; ++k) dst[m][k] = *(const PG8_LAS bf16x8*)(lds + PG8_SA(b, h) + aoff + m * 2048 + k * 1024); } while (0)
#define PG8_LDB(dst, b, h) do { _Pragma("unroll") for (int n = 0; n < 2; ++n) _Pragma("unroll") for (int k = 0; k < 2; ++k) dst[n][k] = *(const PG8_LAS bf16x8*)(lds + PG8_SB(b, h) + boff + n * 2048 + k * 1024); } while (0)
#define PG8_MMA(ai, bj, At, Bt) do { __builtin_amdgcn_s_setprio(1); _Pragma("unroll") for (int m = 0; m < 4; ++m) _Pragma("unroll") for (int n = 0; n < 2; ++n) _Pragma("unroll") for (int k = 0; k < 2; ++k) \
        acc[ai][bj][m][n] = __builtin_amdgcn_mfma_f32_16x16x32_bf16(Bt[n][k], At[m][k], acc[ai][bj][m][n], 0, 0, 0); __builtin_amdgcn_s_setprio(0); } while (0)
#define PG8_WAIT_V(n) asm volatile("s_waitcnt vmcnt(" #n ")" ::: "memory")
#define PG8_WAIT_L(n) asm volatile("s_waitcnt lgkmcnt(" #n ")" ::: "memory")
#define PG8_BAR __builtin_amdgcn_s_barrier()
#define PG8_SCHED __builtin_amdgcn_sched_barrier(0)
    Unit cur, nxt; int ui = 0;
    if (!S.next(0, cur)) return;
    f32x4 acc[2][2][4][2];
#pragma unroll
    for (int a = 0; a < 2; ++a)
#pragma unroll
        for (int b = 0; b < 2; ++b)
#pragma unroll
            for (int m = 0; m < 4; ++m)
#pragma unroll
                for (int n = 0; n < 2; ++n) acc[a][b][m][n] = (f32x4){0.f, 0.f, 0.f, 0.f};
    bf16x8 At[4][2], B0[2][2], B1[2][2];
    const char* cA = (const char*)g.A + (size_t)cur.pm * tstep + (size_t)cur.ko * 2; const char* cB = (const char*)g.Bt + (size_t)cur.pn * tstep + (size_t)cur.ko * 2;
    S.a_ready(cur);
    if constexpr (SP2) {
        PG8_STAGE(PG8_SB(0, 0), cB, voffB); PG8_STAGE(PG8_SB(0, 1), cB + hstep, voffB); PG8_STAGE(PG8_SA(0, 0), cA, voffA); PG8_STAGE(PG8_SA(0, 1), cA + hstep, voffA);
        if (wr == 1) PG8_BAR;
        PG8_WAIT_V(2); PG8_BAR;
        PG8_STAGE(PG8_SB(1, 0), cB + kstep, voffB); PG8_STAGE(PG8_SA(1, 0), cA + kstep, voffA); PG8_STAGE(PG8_SB(1, 1), cB + hstep + kstep, voffB);
        PG8_WAIT_V(6); PG8_BAR;
    } else {
        PG8_STAGE(PG8_SB(0, 0), cB, voffB); PG8_STAGE(PG8_SA(0, 0), cA, voffA); PG8_STAGE(PG8_SB(0, 1), cB + hstep, voffB); PG8_STAGE(PG8_SA(0, 1), cA + hstep, voffA);
        if (wr == 1) PG8_BAR;
        PG8_WAIT_V(4); PG8_BAR;
        PG8_STAGE(PG8_SB(1, 0), cB + kstep, voffB); PG8_STAGE(PG8_SA(1, 0), cA + kstep, voffA); PG8_STAGE(PG8_SB(1, 1), cB + hstep + kstep, voffB);
        PG8_WAIT_V(6); PG8_BAR;
    }
    for (;;) {
        const bool has_next = S.next(ui + 1, nxt);
        const char* nA = has_next ? (const char*)g.A + (size_t)nxt.pm * tstep + (size_t)nxt.ko * 2 : cA; const char* nB = has_next ? (const char*)g.Bt + (size_t)nxt.pn * tstep + (size_t)nxt.ko * 2 : cB;
        for (int t = 0; t < nt; t += 2) {
            const bool last = (t == nt - 2);
            const char* a1 = cA + (size_t)(t + 1) * kstep;
            const char* a2 = last ? nA : cA + (size_t)(t + 2) * kstep; const char* b2 = last ? nB : cB + (size_t)(t + 2) * kstep;
            const char* a3 = a2 + kstep; const char* b3 = b2 + kstep;
            if (last && has_next) S.a_ready(nxt);
            if constexpr (SP2) {
            PG8_LDB(B0, 0, 0); PG8_LDB(B1, 0, 1); PG8_SCHED; PG8_LDA(At, 0, 0); PG8_STAGE(PG8_SA(1, 1), a1 + hstep, voffA);
            PG8_WAIT_V(8); PG8_WAIT_L(0); PG8_BAR; PG8_MMA(0, 0, At, B0); PG8_MMA(0, 1, At, B1); PG8_BAR; PG8_SCHED;
            PG8_LDA(At, 0, 1); PG8_STAGE(PG8_SB(0, 0), b2, voffB); PG8_STAGE(PG8_SB(0, 1), b2 + hstep, voffB); PG8_STAGE(PG8_SA(0, 0), a2, voffA);
            PG8_WAIT_V(8); PG8_WAIT_L(0); PG8_BAR; PG8_MMA(1, 0, At, B0); PG8_MMA(1, 1, At, B1); PG8_BAR; PG8_SCHED;
            PG8_LDB(B0, 1, 0); PG8_LDB(B1, 1, 1); PG8_SCHED; PG8_LDA(At, 1, 0); PG8_STAGE(PG8_SA(0, 1), a2 + hstep, voffA);
            PG8_WAIT_V(8); PG8_WAIT_L(0); PG8_BAR; PG8_MMA(0, 0, At, B0); PG8_MMA(0, 1, At, B1); PG8_BAR; PG8_SCHED;
            PG8_LDA(At, 1, 1); PG8_STAGE(PG8_SB(1, 0), b3, voffB); PG8_STAGE(PG8_SB(1, 1), b3 + hstep, voffB); PG8_STAGE(PG8_SA(1, 0), a3, voffA);
            PG8_WAIT_V(8); PG8_WAIT_L(0); PG8_BAR; PG8_MMA(1, 0, At, B0); PG8_MMA(1, 1, At, B1); PG8_BAR; PG8_SCHED;
            } else {
            PG8_LDB(B0, 0, 0); PG8_SCHED; PG8_LDA(At, 0, 0); PG8_STAGE(PG8_SA(1, 1), a1 + hstep, voffA);
            PG8_WAIT_L(8); PG8_BAR; PG8_WAIT_L(0); PG8_MMA(0, 0, At, B0); PG8_BAR; PG8_SCHED;
            PG8_LDB(B1, 0, 1); PG8_STAGE(PG8_SB(0, 0), b2, voffB);
            PG8_BAR; PG8_WAIT_L(0); PG8_MMA(0, 1, At, B1); PG8_BAR;
            PG8_LDA(At, 0, 1); PG8_STAGE(PG8_SA(0, 0), a2, voffA);
            PG8_BAR; PG8_WAIT_L(0); PG8_MMA(1, 0, At, B0); PG8_BAR; PG8_SCHED;
            PG8_STAGE(PG8_SB(0, 1), b2 + hstep, voffB);
            PG8_WAIT_V(6); PG8_BAR; PG8_MMA(1, 1, At, B1); PG8_BAR;
            PG8_LDB(B0, 1, 0); PG8_SCHED; PG8_LDA(At, 1, 0); PG8_STAGE(PG8_SA(0, 1), a2 + hstep, voffA);
            PG8_WAIT_L(8); PG8_BAR; PG8_WAIT_L(0); PG8_MMA(0, 0, At, B0); PG8_BAR; PG8_SCHED;
            PG8_LDB(B1, 1, 1); PG8_STAGE(PG8_SB(1, 0), b3, voffB);
            PG8_BAR; PG8_WAIT_L(0); PG8_MMA(0, 1, At, B1); PG8_BAR;
            PG8_LDA(At, 1, 1); PG8_STAGE(PG8_SA(1, 0), a3, voffA);
            PG8_BAR; PG8_WAIT_L(0); PG8_MMA(1, 0, At, B0); PG8_BAR; PG8_SCHED;
            PG8_STAGE(PG8_SB(1, 1), b3 + hstep, voffB);
            PG8_WAIT_V(6); PG8_BAR; PG8_MMA(1, 1, At, B1); PG8_BAR;
            }
        }
        if constexpr (ALIGN_EPI) { if (wr == 0) PG8_BAR; }
        if constexpr (!Epi::AFTER_DRAIN) { E(acc, cur, wr, wc, fr, fq); S.done(cur); }
        if (!has_next) break;
#pragma unroll
        for (int a = 0; a < 2; ++a)
#pragma unroll
            for (int b = 0; b < 2; ++b)
#pragma unroll
                for (int m = 0; m < 4; ++m)
#pragma unroll
                    for (int n = 0; n < 2; ++n) acc[a][b][m][n] = (f32x4){0.f, 0.f, 0.f, 0.f};
        cur = nxt; cA = nA; cB = nB; ++ui;
        if constexpr (ALIGN_EPI) { if (wr == 1) PG8_BAR; }
    }
    PG8_WAIT_V(0);
    if constexpr (!ALIGN_EPI) { if (wr == 0) PG8_BAR; }
    PG8_BAR;
    if constexpr (Epi::AFTER_DRAIN) { E.fused(acc, cur, wr, wc, fr, fq, lds, wid, lane); S.done(cur); }
#undef PG8_SA
#undef PG8_SB
#undef PG8_STAGE
#undef PG8_LDA
#undef PG8_LDB
#undef PG8_MMA
#undef PG8_WAIT_V
#undef PG8_WAIT_L
#undef PG8_BAR
#undef PG8_SCHED
}
}
namespace pg8 {
constexpr size_t MIX_MiB = 1u << 20, MIX_UP = 280 * MIX_MiB, MIX_Z = 313 * MIX_MiB, MIX_QP = 346 * MIX_MiB, MIX_KP = 378 * MIX_MiB, MIX_VP = 410 * MIX_MiB, MIX_QS = 278 * MIX_MiB, MIX_KS = 146 * MIX_MiB, MIX_KSS = 33 * MIX_MiB;
constexpr size_t MIX_OKP = 34369536, MIX_OVP = 67923968, MIX_OKS = 102002688, MIX_OVS = 102264832;
typedef unsigned u32x2 __attribute__((ext_vector_type(2)));
__device__ __forceinline__ float sigmoid_f(float x) { return __builtin_amdgcn_rcpf(1.0f + __expf(-x)); }
struct EpiSwiglu {
    static constexpr bool PERM = true, AFTER_DRAIN = false;
    bf16_t* H; int ldh;
    __device__ __forceinline__ void operator()(const f32x4 (&acc)[2][2][4][2], const Unit& u, int wr, int wc, int fr, int fq) const {
        int rb = wr * 64 + fr; asm volatile("" : "+v"(rb));
        const int row0 = u.pm * BM + rb, col0 = u.pn * 128 + wc * 32 + 8 * fq;
#pragma unroll
        for (int ai = 0; ai < 2; ++ai)
#pragma unroll
            for (int m = 0; m < 4; ++m) { bf16_t* rowp = H + (size_t)(row0 + ai * HALF + m * 16) * ldh + col0; u32x4 w;
#pragma unroll
                for (int n = 0; n < 2; ++n) { const f32x4 a = acc[ai][0][m][n], g = acc[ai][1][m][n];
                    const float h0 = a[0] * sigmoid_f(a[0]) * g[0], h1 = a[1] * sigmoid_f(a[1]) * g[1], h2 = a[2] * sigmoid_f(a[2]) * g[2], h3 = a[3] * sigmoid_f(a[3]) * g[3];
                    if (n == 0) { w.x = cvt_pk_bf16(h0, h1); w.y = cvt_pk_bf16(h2, h3); } else { w.z = cvt_pk_bf16(h0, h1); w.w = cvt_pk_bf16(h2, h3); } }
                *(u32x4*)rowp = w; }
    }
};
struct EpiResid {
    static constexpr bool PERM = true, AFTER_DRAIN = false;
    const float* B; float* X; int ldc; float alpha;
    __device__ __forceinline__ void operator()(const f32x4 (&acc)[2][2][4][2], const Unit& u, int wr, int wc, int fr, int fq) const {
        int rb = wr * 64 + fr; asm volatile("" : "+v"(rb));
        const int row0 = u.pm * BM + rb, col0 = u.pn * BM + wc * 32 + 8 * fq;
#pragma unroll
        for (int ai = 0; ai < 2; ++ai)
#pragma unroll
            for (int m = 0; m < 4; ++m) { const size_t ro = (size_t)(row0 + ai * HALF + m * 16) * ldc + col0;
#pragma unroll
                for (int bj = 0; bj < 2; ++bj)
#pragma unroll
                    for (int n = 0; n < 2; ++n) { const f32x4 o = *(const f32x4*)(B + ro + bj * HALF + n * 4) + acc[ai][bj][m][n] * alpha; *(f32x4*)(X + ro + bj * HALF + n * 4) = o; } }
    }
};
struct EpiMixIn {
    static constexpr bool PERM = true, AFTER_DRAIN = false;
    unsigned char* ws; float* out; const float *qn, *kn; int l; float c2;
    __device__ __forceinline__ void operator()(const f32x4 (&acc)[2][2][4][2], const Unit& u, int wr, int wc, int fr, int fq) const {
        const int pn = u.pn; const bool samp = (u.pm == 128);
        int rbase = wr * 64 + fr; asm volatile("" : "+v"(rbase));
        if (pn == 0) {
            float* UP = (float*)(ws + MIX_UP) + ((size_t)u.pm * BM + rbase) * 256 + wc * 32 + 8 * fq;
#pragma unroll
            for (int ai = 0; ai < 2; ++ai)
#pragma unroll
                for (int m = 0; m < 4; ++m) { float* p = UP + (size_t)(ai * HALF + m * 16) * 256;
#pragma unroll
                    for (int bj = 0; bj < 2; ++bj)
#pragma unroll
                        for (int n = 0; n < 2; ++n) *(f32x4*)(p + bj * HALF + n * 4) = acc[ai][bj][m][n];
                    asm volatile("" ::: "memory"); }
        } else if (pn <= 2) {
            float* Z = (float*)(ws + MIX_Z) + ((size_t)u.pm * BM + rbase) * 256 + (pn - 1) * 128 + wc * 32 + 8 * fq;
#pragma unroll
            for (int ai = 0; ai < 2; ++ai)
#pragma unroll
                for (int m = 0; m < 4; ++m) { float* p = Z + (size_t)(ai * HALF + m * 16) * 256;
#pragma unroll
                    for (int n = 0; n < 2; ++n) { const f32x4 a = acc[ai][0][m][n], g = acc[ai][1][m][n]; f32x4 z;
                        z[0] = a[0] * sigmoid_f(g[0]); z[1] = a[1] * sigmoid_f(g[1]); z[2] = a[2] * sigmoid_f(g[2]); z[3] = a[3] * sigmoid_f(g[3]); *(f32x4*)(p + n * 4) = z; }
                    asm volatile("" ::: "memory"); }
        } else {
            const int s = (pn - 3) >> 1, head = 4 * ((pn - 3) & 1) + wc;
            bf16_t* bbase; float* fbase;
            if (!samp) { const size_t g0 = (size_t)u.pm * BM * 512;
                bbase = (bf16_t*)(ws + (s == 0 ? MIX_QP : s == 1 ? MIX_KP : MIX_VP)) + g0; fbase = out + (s == 1 ? MIX_OKP : MIX_OVP) + (size_t)l * 32768 * 512 + g0;
            } else {
                bbase = (s == 0) ? (bf16_t*)(ws + MIX_QS) + 128 * 512 : (bf16_t*)(ws + MIX_KS + (size_t)(2 * l + (s - 1)) * MIX_KSS) + (size_t)4096 * 512;
                fbase = out + (s == 1 ? MIX_OKS : MIX_OVS) + (size_t)l * 256 * 512; }
            const int bstride = samp ? (s == 0 ? 256 : 4224) : 32;
            const float* gn = (s == 0) ? qn : kn;
#pragma unroll
            for (int ai = 0; ai < 2; ++ai)
#pragma unroll
                for (int m = 0; m < 4; ++m) {
                    const int r = ai * HALF + m * 16 + rbase;
                    float sc = 1.0f;
                    if (s < 2) { float ss = 0.f;
#pragma unroll
                        for (int bj = 0; bj < 2; ++bj)
#pragma unroll
                            for (int n = 0; n < 2; ++n) { const f32x4 x = acc[ai][bj][m][n]; ss += (x[0] * x[0] + x[1] * x[1]) + (x[2] * x[2] + x[3] * x[3]); }
                        ss += __shfl_xor(ss, 16); ss += __shfl_xor(ss, 32);
                        sc = rsqrtf(ss * (1.0f / 64.0f) + 1e-6f); if (s == 0) sc *= c2; }
                    asm volatile("" : "+v"(sc));
                    bf16_t* bdst = bbase + ((size_t)(r >> 5) * bstride + (r & 31)) * 512 + head * 64 + 8 * fq;
                    float* fdst = fbase + (size_t)r * 512 + head * 64 + 8 * fq;
#pragma unroll
                    for (int bj = 0; bj < 2; ++bj) { u32x4 w;
#pragma unroll
                        for (int n = 0; n < 2; ++n) { const int dim = 32 * bj + 4 * n; f32x4 x = acc[ai][bj][m][n];
                            if (s < 2) { const f32x4 g = *(const f32x4*)(gn + dim + 8 * fq); x = x * g * sc; }
                            if (s >= 1) *(f32x4*)(fdst + dim) = x;
                            if (n == 0) { w.x = cvt_pk_bf16(x[0], x[1]); w.y = cvt_pk_bf16(x[2], x[3]); } else { w.z = cvt_pk_bf16(x[0], x[1]); w.w = cvt_pk_bf16(x[2], x[3]); } }
                        *(u32x4*)(bdst + 32 * bj) = w; }
                    asm volatile("" ::: "memory"); }
        }
    }
};
struct SplitOrder {
    int nN, nk, kc, pm, c;
    __device__ bool next(int i, Unit& u) const { if (i > 0 || c >= nN * nk) return false; u.pm = pm; u.pn = c % nN; u.ko = (c / nN) * kc; return true; }
    __device__ __forceinline__ void a_ready(const Unit&) const {}
    __device__ __forceinline__ void done(const Unit&) const {}
};
struct EpiResidAtomic {
    static constexpr bool PERM = false, AFTER_DRAIN = false;
    float* X; int ldc; float alpha;
    __device__ __forceinline__ void operator()(const f32x4 (&acc)[2][2][4][2], const Unit& u, int wr, int wc, int fr, int fq) const {
        int rb = wr * 64 + fr; asm volatile("" : "+v"(rb));
        const int row0 = u.pm * BM + rb, col0 = u.pn * BM + wc * 32 + 4 * fq;
#pragma unroll
        for (int ai = 0; ai < 2; ++ai)
#pragma unroll
            for (int m = 0; m < 4; ++m) { float* rowp = X + (size_t)(row0 + ai * HALF + m * 16) * ldc + col0;
#pragma unroll
                for (int bj = 0; bj < 2; ++bj)
#pragma unroll
                    for (int n = 0; n < 2; ++n) { float* p = rowp + bj * HALF + n * 16; const f32x4 v = acc[ai][bj][m][n] * alpha;
                        atomicAdd(p, v[0]); atomicAdd(p + 1, v[1]); atomicAdd(p + 2, v[2]); atomicAdd(p + 3, v[3]); }
                asm volatile("" ::: "memory"); }
    }
};
}
namespace attn_body {
using bf16=__hip_bfloat16;
using bf16x8=__attribute__((ext_vector_type(8)))short;
using s16x4=__attribute__((ext_vector_type(4)))short;
using f32x16=__attribute__((ext_vector_type(16)))float;
using u32x4=__attribute__((ext_vector_type(4)))unsigned;
constexpr int D=64,KVP=512,OP=1024;
typedef float f32x4_t __attribute__((ext_vector_type(4)));
typedef __attribute__((address_space(3))) const float* lds_cfptr;
constexpr int NW=8,QBLK=32,QB=QBLK*NW,KVBLK=64;
__device__ __forceinline__ int crow(int r,int hi){return (r&3)+8*(r>>2)+4*hi;}
#define SBAR() __builtin_amdgcn_sched_barrier(0)
__device__ __forceinline__ void cmask(f32x16&p0,f32x16&p1,int jb,int qrel,int hi){
  const float NEG=-INFINITY; int kb=64*jb+4*hi;
  #pragma unroll
  for(int r=0;r<16;++r){int kv=kb+(r&3)+8*(r>>2); if(kv>qrel)p0[r]=NEG; if(kv+32>qrel)p1[r]=NEG;}
}

constexpr int NSLOT=3, SLOTB=8192;
constexpr int LDS_K=0, LDS_V=NSLOT*SLOTB, LDS_WS=2*NSLOT*SLOTB, LDS_OST=LDS_WS+NW*64*4, LDS_BYTES=LDS_OST+NW*4096;
constexpr float C2=0.125f*1.4426950408889634f;
__device__ __forceinline__ void glds16(const void*gsrc,unsigned lds_dst){unsigned keep;
  asm volatile("s_mov_b32 %0, m0\n\ts_mov_b32 m0, %2\n\ts_nop 0\n\tglobal_load_lds_dwordx4 %1, off\n\ts_mov_b32 m0, %0":"=&s"(keep):"v"(gsrc),"s"(lds_dst):"memory");}
__device__ __forceinline__ float max3f(float a,float b,float c){float r;asm("v_max3_f32 %0, %1, %2, %3":"=v"(r):"v"(a),"v"(b),"v"(c));return r;}
__device__ __forceinline__ float max2f(float a,float b){float r;asm("v_max_f32_e32 %0, %1, %2":"=v"(r):"v"(a),"v"(b));return r;}
__device__ __forceinline__ float fadd_s(float a,float b){float r;asm("v_add_f32_e32 %0, %1, %2":"=v"(r):"v"(a),"v"(b));return r;}
__device__ __forceinline__ float fsub_s(float a,float b){float r;asm("v_sub_f32_e32 %0, %1, %2":"=v"(r):"v"(a),"v"(b));return r;}
typedef float f32x2_t __attribute__((ext_vector_type(2))); typedef __bf16 bf16x2_t __attribute__((ext_vector_type(2)));
__device__ __forceinline__ unsigned cvtpk_s(float lo,float hi){f32x2_t v={lo,hi};bf16x2_t b=__builtin_convertvector(v,bf16x2_t);return __builtin_bit_cast(unsigned,b);}
#define WAIT_BAR(N) asm volatile("s_waitcnt vmcnt(" #N ") lgkmcnt(0)\n\ts_barrier":::"memory")

__device__ __forceinline__ void qkt(f32x16&p0,f32x16&p1,const char*Kslot,const bf16x8*qr,int r32,int hi){
  const char*kb=Kslot+hi*1024+r32*16;
  #pragma unroll
  for(int d0=0;d0<4;++d0){
    const bf16x8 b0=*reinterpret_cast<const bf16x8*>(kb+d0*2048);
    const bf16x8 b1=*reinterpret_cast<const bf16x8*>(kb+d0*2048+512);
    p0=__builtin_amdgcn_mfma_f32_32x32x16_bf16(b0,qr[d0],p0,0,0,0);p1=__builtin_amdgcn_mfma_f32_32x32x16_bf16(b1,qr[d0],p1,0,0,0);}
}
typedef __attribute__((address_space(3))) const char* lds_cptr;
typedef short v4i16_t __attribute__((ext_vector_type(4)));
__device__ __forceinline__ void kload8(bf16x8*kf,lds_cptr kp){
  kf[0]=*(const __attribute__((address_space(3))) bf16x8*)(kp);      kf[1]=*(const __attribute__((address_space(3))) bf16x8*)(kp+512);
  kf[2]=*(const __attribute__((address_space(3))) bf16x8*)(kp+2048); kf[3]=*(const __attribute__((address_space(3))) bf16x8*)(kp+2560);
  kf[4]=*(const __attribute__((address_space(3))) bf16x8*)(kp+4096); kf[5]=*(const __attribute__((address_space(3))) bf16x8*)(kp+4608);
  kf[6]=*(const __attribute__((address_space(3))) bf16x8*)(kp+6144); kf[7]=*(const __attribute__((address_space(3))) bf16x8*)(kp+6656);
}
__device__ __forceinline__ void kload2(bf16x8*kf,lds_cptr kp,int j){ kf[2*j]=*(const __attribute__((address_space(3))) bf16x8*)(kp+j*2048); kf[2*j+1]=*(const __attribute__((address_space(3))) bf16x8*)(kp+j*2048+512); }
__device__ __forceinline__ s16x4 vtr(lds_cptr p){ return __builtin_bit_cast(s16x4,__builtin_amdgcn_ds_read_tr16_b64_v4i16((__attribute__((address_space(3))) v4i16_t*)p)); }
__device__ __forceinline__ float rowmax(const f32x16&p0,const f32x16&p1){
  float a=max3f(p0[0],p0[1],p1[0]),b=max3f(p0[2],p0[3],p1[1]);a=max3f(a,p1[2],p1[3]);
  #pragma unroll
  for(int r=4;r<16;r+=4){a=max3f(a,p0[r],p0[r+1]);b=max3f(b,p0[r+2],p0[r+3]);a=max3f(a,p1[r],p1[r+1]);b=max3f(b,p1[r+2],p1[r+3]);}
  const float m=max2f(a,b);
  auto rr=__builtin_amdgcn_permlane32_swap(__float_as_uint(m),__float_as_uint(m),false,false);
  return max2f(__uint_as_float(rr[0]),__uint_as_float(rr[1]));
}
__device__ __forceinline__ void pv(f32x16*o,int vb,bf16x8 pa0,bf16x8 pa1,bf16x8 pa2,bf16x8 pa3){
  #pragma unroll
  for(int d0=0;d0<2;++d0){s16x4 lo[4],hi[4];
    #pragma unroll
    for(int ks=0;ks<4;++ks){
      asm volatile("ds_read_b64_tr_b16 %0,%1 offset:%c2":"=&v"(lo[ks]):"v"(vb),"i"(d0*4096+ks*1024):"memory");
      asm volatile("ds_read_b64_tr_b16 %0,%1 offset:%c2":"=&v"(hi[ks]):"v"(vb),"i"(d0*4096+ks*1024+512):"memory");}
    asm volatile("s_waitcnt lgkmcnt(0)":::"memory");SBAR();
    #define PK(k) (bf16x8){lo[k][0],lo[k][1],lo[k][2],lo[k][3],hi[k][0],hi[k][1],hi[k][2],hi[k][3]}
    o[d0]=__builtin_amdgcn_mfma_f32_32x32x16_bf16(pa0,PK(0),o[d0],0,0,0);
    o[d0]=__builtin_amdgcn_mfma_f32_32x32x16_bf16(pa1,PK(1),o[d0],0,0,0);
    o[d0]=__builtin_amdgcn_mfma_f32_32x32x16_bf16(pa2,PK(2),o[d0],0,0,0);
    o[d0]=__builtin_amdgcn_mfma_f32_32x32x16_bf16(pa3,PK(3),o[d0],0,0,0);
    #undef PK
  }
}

#ifndef ATTN_STORE16
#define ATTN_STORE16(p,v) (*(u32x4*)(p)=(v))
#endif
template<int THRL> __device__ __forceinline__ void attn_unit(const bf16*Qu,const bf16*__restrict__ Kh,const bf16*__restrict__ Vh,bf16*Ou,const int NT,const int store_mask,lds_cfptr ck2,char*shm){
  int tid=threadIdx.x; asm volatile("":"+v"(tid)); const int lane=tid&63,r32=lane&31,hi=lane>>5; const int wid=__builtin_amdgcn_readfirstlane(tid>>6);
  const bf16*Qw=Qu+(long)(wid*QBLK)*KVP;
  const unsigned lds0=(unsigned)(uintptr_t)shm;
  float*wsf=(float*)(shm+LDS_WS)+wid*64;
  const bf16*ksrc=Kh+(long)lane*KVP+wid*8;
  const bf16*vsrc=Vh+(long)(16*(wid&3)+(lane>>2))*KVP+(wid>>2)*32+(lane&3)*8;
  const unsigned kdst=lds0+LDS_K+wid*1024, vdst=lds0+LDS_V+wid*1024;
  #define DMA_K(t,slot) glds16(ksrc+(long)(t)*KVBLK*KVP,(unsigned)__builtin_amdgcn_readfirstlane(kdst+(slot)))
  #define DMA_V(t,slot) glds16(vsrc+(long)(t)*KVBLK*KVP,(unsigned)__builtin_amdgcn_readfirstlane(vdst+(slot)))
  const int vb0=(int)(lds0+LDS_V)+((lane>>4)&1)*32+(lane&3)*8+(4*hi+((lane&15)>>2))*64;
  const char*Kbase=shm+LDS_K; bf16x8 kf[8];
  const lds_cptr shm3=(lds_cptr)shm; const lds_cptr kp0=shm3+LDS_K+hi*1024+r32*16; const lds_cptr vp0=shm3+LDS_V+((lane>>4)&1)*32+(lane&3)*8+(4*hi+((lane&15)>>2))*64;
  DMA_K(0,0);DMA_V(0,0);DMA_K(1,SLOTB);
  bf16x8 qr[4];
  #pragma unroll
  for(int d0=0;d0<4;++d0)qr[d0]=*reinterpret_cast<const bf16x8*>(&Qw[(long)r32*KVP+d0*16+hi*8]);
  float mhat=0.f,l_reg=0.f;f32x16 o[2];o[0]=f32x16{};o[1]=f32x16{};
  const int qrel=wid*QBLK+r32;
  #define PREFILL(P0,P1,t) do{ const lds_cfptr cb_=ck2+64*(t)+4*hi; const float nm_=-mhat; \
    _Pragma("unroll") for(int j_=0;j_<4;++j_){ const f32x4_t a_=*(const __attribute__((address_space(3))) f32x4_t*)(cb_+8*j_); const f32x4_t b_=*(const __attribute__((address_space(3))) f32x4_t*)(cb_+32+8*j_); \
      P0[4*j_]=nm_-a_[0];P0[4*j_+1]=nm_-a_[1];P0[4*j_+2]=nm_-a_[2];P0[4*j_+3]=nm_-a_[3]; P1[4*j_]=nm_-b_[0];P1[4*j_+1]=nm_-b_[1];P1[4*j_+2]=nm_-b_[2];P1[4*j_+3]=nm_-b_[3]; } }while(0)
  #define CMASK(P0,P1,t) do{int jb_=(t)-(NT-4); if(jb_>=0)cmask(P0,P1,jb_,qrel,hi);}while(0)
  bool resc=false;
  #define START(P0,P1) do{ const float rm=rowmax(P0,P1); resc=false; \
    { const float dl=rm; mhat=fadd_s(mhat,dl); \
      _Pragma("unroll") for(int r=0;r<16;++r){P0[r]=fsub_s(P0[r],dl);P1[r]=fsub_s(P1[r],dl);} \
      } \
    _Pragma("unroll") for(int r=0;r<16;++r)P0[r]=__builtin_amdgcn_exp2f(P0[r]); }while(0)
  #define RESC() do{ if(resc){ asm volatile("s_waitcnt lgkmcnt(0)":::"memory"); \
      _Pragma("unroll") for(int d_=0;d_<2;++d_) _Pragma("unroll") for(int r=0;r<16;++r)o[d_][r]*=wsf[crow(r,hi)]; } }while(0)
  f32x16 pA0,pA1,pB0,pB1;
  int sl_prev=0,sl_cur=0,sl_next=SLOTB;
  #define ROT() do{sl_prev=sl_cur;sl_cur=sl_next;sl_next=(sl_next==(NSLOT-1)*SLOTB)?0:sl_next+SLOTB;}while(0)
  DMA_K(2,2*SLOTB);
  WAIT_BAR(3);
  PREFILL(pA0,pA1,0);qkt(pA0,pA1,Kbase,qr,r32,hi);asm volatile("s_nop 15\n\ts_nop 7":"+v"(pA0),"+v"(pA1));CMASK(pA0,pA1,0);
  START(pA0,pA1);
  _Pragma("unroll") for(int r=0;r<16;++r)pA1[r]=__builtin_amdgcn_exp2f(pA1[r]);
  WAIT_BAR(0);
  DMA_K(3,0);DMA_V(1,SLOTB);
  ROT();
  kload8(kf,kp0+sl_cur);
  WAIT_BAR(2);
  s16x4 vlo[8],vhi[8]; u32x4 pw0,pw1,pw2,pw3;
  #define PKW(P,B) cvtpk_s(P[B],P[B+1])
  #define PAF(k) __builtin_bit_cast(bf16x8,pw##k)
  #define VFR(i) (bf16x8){vlo[i][0],vlo[i][1],vlo[i][2],vlo[i][3],vhi[i][0],vhi[i][1],vhi[i][2],vhi[i][3]}
  #define PIN(x) asm volatile("":"+v"(x))
  #define MX3(a,b,c) __builtin_fmaxf(__builtin_fmaxf((a),(b)),(c))
  #define GAPA(MF,A0,A1,A2,A3,W0,W1,PW) do{ MF; sacc+=A0; sacc+=A1; sacc+=A2; sacc+=A3; PIN(sacc); W0; W1; PIN(PW); SBAR(); }while(0)
  #define EX(v) __builtin_amdgcn_exp2f(v)
  #define GAPB(MF,X,B) do{ MF; X[B]=EX(X[B]); X[B+1]=EX(X[B+1]); X[B+2]=EX(X[B+2]); X[B+3]=EX(X[B+3]); PIN(X); SBAR(); }while(0)
  #define VRD(i) do{ vlo[i]=vtr(vp_+(((i)>>2)*4096+((i)&3)*1024)); vhi[i]=vtr(vp_+(((i)>>2)*4096+((i)&3)*1024+512)); }while(0)
  #define KRD(G,j) do{ if(G){ kload2(kf,kp0+sl_next,j); SBAR(); } }while(0)
  #define STEP(C0,C1,P0,P1,t,GK,GV,GL) do{ SBAR(); \
    const lds_cptr vp_=vp0+sl_prev; \
    PREFILL(C0,C1,t); SBAR(); \
    VRD(0); SBAR(); float sacc=(P0[0]+P0[1]); \
    GAPA(C0=__builtin_amdgcn_mfma_f32_32x32x16_bf16(kf[0],qr[0],C0,0,0,0), P0[2],P0[3],P0[4],P0[5],     pw0[0]=PKW(P0,0), pw0[1]=PKW(P0,2), pw0); \
    VRD(4); SBAR(); GAPA(C1=__builtin_amdgcn_mfma_f32_32x32x16_bf16(kf[1],qr[0],C1,0,0,0), P0[6],P0[7],P0[8],P0[9],     pw0[2]=PKW(P0,4), pw0[3]=PKW(P0,6), pw0); \
    VRD(1); SBAR(); GAPA(C0=__builtin_amdgcn_mfma_f32_32x32x16_bf16(kf[2],qr[1],C0,0,0,0),   P0[10],P0[11],P0[12],P0[13], pw1[0]=PKW(P0,8), pw1[1]=PKW(P0,10), pw1); \
    VRD(5); SBAR(); GAPA(C1=__builtin_amdgcn_mfma_f32_32x32x16_bf16(kf[3],qr[1],C1,0,0,0),   P0[14],P0[15],P1[0],P1[1],   pw1[2]=PKW(P0,12),pw1[3]=PKW(P0,14), pw1); \
    VRD(2); SBAR(); GAPA(C0=__builtin_amdgcn_mfma_f32_32x32x16_bf16(kf[4],qr[2],C0,0,0,0),   P1[2],P1[3],P1[4],P1[5],     pw2[0]=PKW(P1,0), pw2[1]=PKW(P1,2), pw2); \
    VRD(6); SBAR(); GAPA(C1=__builtin_amdgcn_mfma_f32_32x32x16_bf16(kf[5],qr[2],C1,0,0,0),   P1[6],P1[7],P1[8],P1[9],     pw2[2]=PKW(P1,4), pw2[3]=PKW(P1,6), pw2); \
    VRD(3); SBAR(); GAPA(C0=__builtin_amdgcn_mfma_f32_32x32x16_bf16(kf[6],qr[3],C0,0,0,0),   P1[10],P1[11],P1[12],P1[13], pw3[0]=PKW(P1,8), pw3[1]=PKW(P1,10), pw3); \
    VRD(7); SBAR(); GAPA(C1=__builtin_amdgcn_mfma_f32_32x32x16_bf16(kf[7],qr[3],C1,0,0,0),   P1[14],P1[15],0.f,0.f,       pw3[2]=PKW(P1,12),pw3[3]=PKW(P1,14), pw3); \
    l_reg+=sacc; \
    if(GK){DMA_K((t)+3,sl_cur);} if(GV){DMA_V((t)+1,sl_next);} \
    CMASK(C0,C1,t); \
    { float a=MX3(C0[0],C0[1],C1[0]),b=MX3(C0[2],C0[3],C1[1]); a=MX3(a,C1[2],C1[3]); \
      _Pragma("unroll") for(int r=4;r<16;r+=4){a=MX3(a,C0[r],C0[r+1]);b=MX3(b,C0[r+2],C0[r+3]);a=MX3(a,C1[r],C1[r+1]);b=MX3(b,C1[r+2],C1[r+3]);} \
      float rm=__builtin_fmaxf(a,b); { auto rr=__builtin_amdgcn_permlane32_swap(__float_as_uint(rm),__float_as_uint(rm),false,false); rm=__builtin_fmaxf(__uint_as_float(rr[0]),__uint_as_float(rr[1])); } \
      resc=false; \
      if(__builtin_expect(__any(rm>(float)THRL),0)){ const float dl=__builtin_fmaxf(rm,0.f); mhat+=dl; \
        _Pragma("unroll") for(int r=0;r<16;++r){C0[r]-=dl;C1[r]-=dl;} \
        const float f=__builtin_amdgcn_exp2f(-dl); l_reg*=f; if(hi==0)wsf[r32]=f; resc=true; } } \
    SBAR(); \
    GAPB(o[0]=__builtin_amdgcn_mfma_f32_32x32x16_bf16(PAF(0),VFR(0),o[0],0,0,0), C0,0); \
    GAPB(o[1]=__builtin_amdgcn_mfma_f32_32x32x16_bf16(PAF(0),VFR(4),o[1],0,0,0), C0,4); \
    KRD(GL,0); GAPB(o[0]=__builtin_amdgcn_mfma_f32_32x32x16_bf16(PAF(1),VFR(1),o[0],0,0,0), C0,8); \
    KRD(GL,1); GAPB(o[1]=__builtin_amdgcn_mfma_f32_32x32x16_bf16(PAF(1),VFR(5),o[1],0,0,0), C0,12); \
    KRD(GL,2); GAPB(o[0]=__builtin_amdgcn_mfma_f32_32x32x16_bf16(PAF(2),VFR(2),o[0],0,0,0), C1,0); \
    KRD(GL,3); GAPB(o[1]=__builtin_amdgcn_mfma_f32_32x32x16_bf16(PAF(2),VFR(6),o[1],0,0,0), C1,4); \
    GAPB(o[0]=__builtin_amdgcn_mfma_f32_32x32x16_bf16(PAF(3),VFR(3),o[0],0,0,0), C1,8); \
    GAPB(o[1]=__builtin_amdgcn_mfma_f32_32x32x16_bf16(PAF(3),VFR(7),o[1],0,0,0), C1,12); \
    }while(0)
  int t=1;
  #undef CMASK
  #define CMASK(P0,P1,t) do{}while(0)
  for(;t+5<NT;t+=2){
    STEP(pB0,pB1,pA0,pA1,t,true,true,true);     WAIT_BAR(2); RESC(); ROT();
    STEP(pA0,pA1,pB0,pB1,t+1,true,true,true);   WAIT_BAR(2); RESC(); ROT();
  }
  #undef CMASK
  #define CMASK(P0,P1,t) do{int jb_=(t)-(NT-4); if(jb_>=0)cmask(P0,P1,jb_,qrel,hi);}while(0)
  #define ENDW(tt) do{ if((tt)+3<NT){WAIT_BAR(2);} else if((tt)+2<NT){WAIT_BAR(1);} else {WAIT_BAR(0);} }while(0)
  for(;t+1<NT;t+=2){
    STEP(pB0,pB1,pA0,pA1,t,(t+3<NT),(t+1<NT),(t+1<NT));       ENDW(t);   RESC(); ROT();
    STEP(pA0,pA1,pB0,pB1,t+1,(t+4<NT),(t+2<NT),(t+2<NT));     ENDW(t+1); RESC(); ROT();
  }
  STEP(pB0,pB1,pA0,pA1,NT-1,false,false,false); RESC();
  { float sacc=pB0[0]+pB0[1]; _Pragma("unroll") for(int r=2;r<16;++r)sacc+=pB0[r]; _Pragma("unroll") for(int r=0;r<16;++r)sacc+=pB1[r]; l_reg+=sacc;
    pw0=(u32x4){PKW(pB0,0),PKW(pB0,2),PKW(pB0,4),PKW(pB0,6)};pw1=(u32x4){PKW(pB0,8),PKW(pB0,10),PKW(pB0,12),PKW(pB0,14)};pw2=(u32x4){PKW(pB1,0),PKW(pB1,2),PKW(pB1,4),PKW(pB1,6)};pw3=(u32x4){PKW(pB1,8),PKW(pB1,10),PKW(pB1,12),PKW(pB1,14)};
    SBAR(); pv(o,vb0+sl_cur,PAF(0),PAF(1),PAF(2),PAF(3)); }
  #undef PKW
  #undef PAF
  #undef VFR
  #undef PIN
  #undef MX3
  #undef GAPA
  #undef GAPB
  #undef EX
  #undef VRD
  #undef KRD
  #undef STEP
  #undef ENDW
  {auto rr=__builtin_amdgcn_permlane32_swap(__float_as_uint(l_reg),__float_as_uint(l_reg),false,false);l_reg=__uint_as_float(rr[0])+__uint_as_float(rr[1]);}
  if(hi==0)wsf[32+r32]=l_reg;asm volatile("s_waitcnt lgkmcnt(0)":::"memory");
  float rli[16];
  #pragma unroll
  for(int r=0;r<16;++r)rli[r]=__builtin_amdgcn_rcpf(wsf[32+crow(r,hi)]);
  bf16*Ow=Ou+(long)(wid*QBLK)*OP;
  { bf16*stg=(bf16*)(shm+LDS_OST)+wid*2048;
    #pragma unroll
    for(int r=0;r<16;++r){const int orow=crow(r,hi);
      #pragma unroll
      for(int d0=0;d0<2;++d0)stg[orow*64+d0*32+r32]=__float2bfloat16(o[d0][r]*rli[r]);}
    asm volatile("s_waitcnt lgkmcnt(0)":::"memory");
    #pragma unroll
    for(int i=0;i<4;++i){const int row=i*8+(lane>>3),ch=lane&7; const u32x4 v=*(const u32x4*)(stg+row*64+ch*8); if((store_mask>>wid)&1)ATTN_STORE16(Ow+(long)row*OP+ch*8,v);} }
  asm volatile("s_waitcnt lgkmcnt(0)\n\ts_barrier":::"memory");
  #undef DMA_K
  #undef DMA_V
  #undef CMASK
  #undef PREFILL
  #undef START
  #undef RESC
  #undef ROT
}
constexpr int ATTN_LDS_BYTES=LDS_BYTES;
#undef SBAR
#undef WAIT_BAR
}
#ifndef MK_PER_PHASE
#define MK_PER_PHASE 0
#endif
#define LAS __attribute__((address_space(3)))
typedef unsigned short bf16u;
typedef float f32x4 __attribute__((ext_vector_type(4)));
typedef unsigned u32x2 __attribute__((ext_vector_type(2)));
typedef unsigned u32x4 __attribute__((ext_vector_type(4)));
constexpr int DM = 1024, BATCH = 16, SEQ = 2048, DECB = 8, DECS = 32, PAST = 4096;
constexpr int MP = BATCH * SEQ, MS = DECB * DECS, MT = MP + MS;
constexpr int DIN = 2312, DFF = 2816, NGU = 2 * DFF, NMIX = 2304, SKV = 4224;
constexpr float LOG2E = 1.4426950408889634f;
constexpr size_t O_Y = 0, O_YS = 33554432, O_POOLP = 33816576, O_POOLS = 33939456, O_CONVP = 34000896, O_CONVS = 34246656, O_KP = 34369536, O_VP = 67923968, O_FP = 101478400,
                 O_KS = 102002688, O_VS = 102264832, O_FS = 102526976, O_END = 102531072;
constexpr size_t MiB = 1u << 20;
constexpr size_t WS_CTL = 0, CTL_BYTES = 32768;
constexpr int CW_BAR = 1024;
constexpr size_t WS_W = 1 * MiB, WL_STRIDE = 40 * MiB;
constexpr size_t WL_GU1 = 0, WL_D1 = 11 * MiB, WL_IN = 16 * MiB + MiB / 2, WL_OUT = 21 * MiB, WL_GU2 = 23 * MiB, WL_D2 = 34 * MiB;
constexpr size_t WS_XN = 81 * MiB;
constexpr size_t WS_KS = 146 * MiB, KS_STRIDE = 33 * MiB;
constexpr size_t WS_QS = 278 * MiB;
constexpr size_t WS_H = 280 * MiB;
constexpr size_t WS_UP = 280 * MiB, WS_Z = 313 * MiB, WS_QP = 346 * MiB, WS_KP = 378 * MiB, WS_VP = 410 * MiB, WS_END = 458 * MiB;
static_assert(WS_XN + (size_t)MT * 1024 * 2 <= WS_KS && WS_H + (size_t)MT * DFF * 2 <= WS_END && WS_UP + (size_t)MT * 256 * 4 <= WS_Z && WS_Z + (size_t)MT * 256 * 4 <= WS_QP, "ws map");
static_assert(pg8::MIX_UP == WS_UP && pg8::MIX_Z == WS_Z && pg8::MIX_QP == WS_QP && pg8::MIX_KP == WS_KP && pg8::MIX_VP == WS_VP && pg8::MIX_QS == WS_QS && pg8::MIX_KS == WS_KS && pg8::MIX_KSS == KS_STRIDE && pg8::MIX_OKP == O_KP && pg8::MIX_OVP == O_VP && pg8::MIX_OKS == O_KS && pg8::MIX_OVS == O_VS, "epilogue constants");
static_assert(WL_D2 + (size_t)DM * DFF * 2 <= WL_STRIDE && (size_t)8 * SKV * 512 * 2 <= KS_STRIDE, "ws map 2");
constexpr int RING_BYTES = 131072, MISC_OFF = RING_BYTES + 320, LDS_BYTES = 147456;
constexpr int CK2_OFF = 86016;
static_assert(attn_body::ATTN_LDS_BYTES <= CK2_OFF && CK2_OFF + SKV * 4 + 64 <= RING_BYTES, "lds map");

__device__ __forceinline__ unsigned f2bf(float f) { unsigned u = __builtin_bit_cast(unsigned, f); return (u + 0x7fffu + ((u >> 16) & 1u)) >> 16; }
__device__ __forceinline__ unsigned pk2(float lo, float hi) { return f2bf(lo) | (f2bf(hi) << 16); }
__device__ __forceinline__ float wave_sum(float v) {
#pragma unroll
    for (int o = 1; o < 64; o <<= 1) v += __shfl_xor(v, o);
    return v;
}

__device__ __forceinline__ void tr_item(const float* W, int ldw, int sc0, const float* gain, bf16u* WT, int Kdim, int j0, int k0, float* scr, int lane) {
#pragma unroll
    for (int i = 0; i < 8; ++i) { const int kk = 8 * i + (lane >> 3), c4 = 4 * (lane & 7); f32x4 w = *(const f32x4*)(W + (size_t)(k0 + kk) * ldw + sc0 + c4); if (gain) w = w * gain[k0 + kk];
        float* d = scr + kk * 33 + c4; d[0] = w.x; d[1] = w.y; d[2] = w.z; d[3] = w.w; }
    __builtin_amdgcn_wave_barrier(); asm volatile("s_waitcnt lgkmcnt(0)" ::: "memory");
    const int c = lane & 7;
#pragma unroll
    for (int j = 0; j < 4; ++j) { const int n = (lane >> 3) + 8 * j; const float* s = scr + (8 * c) * 33 + n;
        u32x4 o; o.x = pk2(s[0 * 33], s[1 * 33]); o.y = pk2(s[2 * 33], s[3 * 33]); o.z = pk2(s[4 * 33], s[5 * 33]); o.w = pk2(s[6 * 33], s[7 * 33]);
        *(u32x4*)(WT + (size_t)(j0 + n) * Kdim + k0 + 8 * c) = o; }
    __builtin_amdgcn_wave_barrier(); asm volatile("s_waitcnt lgkmcnt(0)" ::: "memory");
}
__device__ __forceinline__ int gu_src(int j0) { const int pn = j0 >> 8, r = j0 & 255; return r < 128 ? 128 * pn + r : DFF + 128 * pn + (r - 128); }
__device__ __forceinline__ int in_src(int j0) {
    const int pn = j0 >> 8, r = j0 & 255;
    if (pn == 0) return r;
    if (pn <= 2) return r < 128 ? 256 + 128 * (pn - 1) + r : 512 + 128 * (pn - 1) + (r - 128);
    const int s = (pn - 3) >> 1, p = (pn - 3) & 1, bj = r >> 7, wc = (r >> 5) & 3;
    return 768 + 512 * s + (4 * p + wc) * 64 + 32 * bj + (r & 31);
}

struct Args { const float* in[25]; float* out; unsigned char* ws; int ph_lo, ph_hi; };
typedef const __attribute__((address_space(4))) Args* ArgsP;
#define ARGS_OPAQUE(a) asm volatile("" : "+s"(a))

template <bool FORGET>
__device__ __forceinline__ void rms_phase(unsigned char* lds, const float* srcP, const float* srcS, float* copy_dst, bf16u* XN,
                                          const float* gain, const float* w_in_l, const float* fb, float* logfP, float* logfS) {
    int tid = threadIdx.x; asm volatile("" : "+v"(tid));
    const int lane = tid & 63, wave = tid >> 6;
    float* WFt = (float*)lds;
    if (FORGET) {
        for (int e = tid; e < 8192; e += 512) { const int k = e >> 3, h = e & 7; WFt[h * 1024 + k] = gain[k] * w_in_l[(size_t)k * DIN + 2304 + h]; }
        __syncthreads();
    }
    const int gw = blockIdx.x * 8 + wave, NGW = gridDim.x * 8;
    for (int m = gw; m < MT; m += NGW) {
        const float* xr = (m < MP) ? srcP + (size_t)m * DM : srcS + (size_t)(m - MP) * DM;
        f32x4 v[4]; float ss = 0.f;
#pragma unroll
        for (int j = 0; j < 4; ++j) { v[j] = ((const f32x4*)xr)[lane + 64 * j]; ss += (v[j].x * v[j].x + v[j].y * v[j].y) + (v[j].z * v[j].z + v[j].w * v[j].w); }
        ss = wave_sum(ss);
        const float rstd = rsqrtf(ss * (1.0f / DM) + 1e-6f);
        if (copy_dst && m >= MP) {
#pragma unroll
            for (int j = 0; j < 4; ++j) ((f32x4*)(copy_dst + (size_t)m * DM))[lane + 64 * j] = v[j];
        }
#pragma unroll
        for (int j = 0; j < 4; ++j) { v[j] = v[j] * rstd; u32x2 w; w.x = pk2(v[j].x, v[j].y); w.y = pk2(v[j].z, v[j].w); ((u32x2*)(XN + (size_t)m * DM))[lane + 64 * j] = w; }
        if (FORGET) {
            float sh[8];
#pragma unroll
            for (int h = 0; h < 8; ++h) { float s = 0.f;
#pragma unroll
                for (int j = 0; j < 4; ++j) { const f32x4 w = *(const f32x4*)(WFt + h * 1024 + 256 * j + 4 * lane); s += (v[j].x * w.x + v[j].y * w.y) + (v[j].z * w.z + v[j].w * w.w); }
                sh[h] = s; }
#define BPX(x, m_) __builtin_bit_cast(float, __builtin_amdgcn_ds_bpermute((lane ^ (m_)) << 2, __builtin_bit_cast(int, (x))))
            float t4[4], u2[2], wv;
            { const bool o = lane & 1;
#pragma unroll
              for (int i = 0; i < 4; ++i) { const float snd = o ? sh[i] : sh[4 + i], kp = o ? sh[4 + i] : sh[i]; t4[i] = kp + BPX(snd, 1); } }
            { const bool o = lane & 2;
#pragma unroll
              for (int i = 0; i < 2; ++i) { const float snd = o ? t4[i] : t4[2 + i], kp = o ? t4[2 + i] : t4[i]; u2[i] = kp + BPX(snd, 2); } }
            { const bool o = lane & 4; const float snd = o ? u2[0] : u2[1], kp = o ? u2[1] : u2[0]; wv = kp + BPX(snd, 4); }
            wv += BPX(wv, 8); wv += BPX(wv, 16); wv += BPX(wv, 32);
#undef BPX
            const int hh = ((lane & 1) << 2) | (lane & 2) | ((lane >> 2) & 1);
            if (lane < 8) { const float x = wv + fb[hh]; const float lf = (x < 0.f) ? x - log1pf(expf(x)) : -log1pf(expf(-x));
                float* dst = (m < MP) ? logfP + (size_t)m * 8 : logfS + (size_t)(m - MP) * 8; dst[hh] = lf; }
        }
    }
}

constexpr int I_GU = 16 * 176, I_D = 44 * 32, I_IN = 16 * 72, I_OUT = 12 * 32, I_L = 2 * I_GU + 2 * I_D + I_IN + I_OUT;
constexpr int I_W = 2 * I_L, I_C = 2 * 2 * 8 * 528, I_P = 128;
__device__ __forceinline__ void conv_item(ArgsP a, int it, float* scr, int lane) {
    if (it < I_W) {
            const int l = it / I_L; int r = it % I_L; unsigned char* wl = a->ws + WS_W + (size_t)l * WL_STRIDE;
            if (r < I_GU) { const int kb = r / 176, j0 = 32 * (r % 176); tr_item(a->in[8] + (size_t)l * DM * NGU, NGU, gu_src(j0), a->in[7] + l * DM, (bf16u*)(wl + WL_GU1), DM, j0, 64 * kb, scr, lane); return; } r -= I_GU;
            if (r < I_D) { const int kb = r / 32, j0 = 32 * (r % 32); tr_item(a->in[9] + (size_t)l * DFF * DM, DM, j0, nullptr, (bf16u*)(wl + WL_D1), DFF, j0, 64 * kb, scr, lane); return; } r -= I_D;
            if (r < I_IN) { const int kb = r / 72, j0 = 32 * (r % 72); tr_item(a->in[11] + (size_t)l * DM * DIN, DIN, in_src(j0), a->in[10] + l * DM, (bf16u*)(wl + WL_IN), DM, j0, 64 * kb, scr, lane); return; } r -= I_IN;
            if (r < I_OUT) { const int kb = 4 + r / 32, j0 = 32 * (r % 32); tr_item(a->in[12] + (size_t)l * DM * DM, DM, j0, nullptr, (bf16u*)(wl + WL_OUT), DM, j0, 64 * kb, scr, lane); return; } r -= I_OUT;
            if (r < I_GU) { const int kb = r / 176, j0 = 32 * (r % 176); tr_item(a->in[23] + (size_t)l * DM * NGU, NGU, gu_src(j0), a->in[22] + l * DM, (bf16u*)(wl + WL_GU2), DM, j0, 64 * kb, scr, lane); return; } r -= I_GU;
            { const int kb = r / 32, j0 = 32 * (r % 32); tr_item(a->in[24] + (size_t)l * DFF * DM, DM, j0, nullptr, (bf16u*)(wl + WL_D2), DFF, j0, 64 * kb, scr, lane); }
    } else {
            int r = it - I_W; const int l = r / 8448; r %= 8448; const int kv = r / 4224; r %= 4224; const int b = r / 528, r8 = r % 528;
            const float* src = a->in[4 + kv] + ((size_t)(l * 8 + b) * PAST) * 512;
            bf16u* dst = (bf16u*)(a->ws + WS_KS + (size_t)(2 * l + kv) * KS_STRIDE) + (size_t)b * SKV * 512;
            const int row0 = r8 * 8;
            if (row0 >= 4096 && row0 < 4128) return;
#pragma unroll
            for (int i = 0; i < 8; ++i) { const int row = row0 + i;
#pragma unroll
                for (int q = 0; q < 2; ++q) { f32x4 v = (f32x4){0.f, 0.f, 0.f, 0.f}; if (row0 < 4096) v = ((const f32x4*)(src + (size_t)row * 512))[lane + 64 * q];
                    u32x2 w; w.x = pk2(v.x, v.y); w.y = pk2(v.z, v.w); ((u32x2*)(dst + (size_t)row * 512))[lane + 64 * q] = w; } }
    }
}
__device__ __forceinline__ void fold_item(ArgsP a, int it, int lane) {
            const int r = it, l = r >> 6, g = (r >> 4) & 3, nb = r & 15, n = 64 * nb + lane;
            const float* wo = a->in[12] + (size_t)l * DM * DM; const float* ps = a->in[14] + l * 256 + g * 64; const float* pw = a->in[13] + (size_t)(l * 4 + g) * 4096;
            bf16u* wt = (bf16u*)(a->ws + WS_W + (size_t)l * WL_STRIDE + WL_OUT);
            float wreg[64];
#pragma unroll
            for (int dd = 0; dd < 64; ++dd) wreg[dd] = ps[dd] * wo[(size_t)(g * 64 + dd) * DM + n];
            for (int c = 0; c < 64; c += 2) { float a0 = 0.f, a1 = 0.f;
#pragma unroll
                for (int dd = 0; dd < 64; ++dd) { a0 += pw[c * 64 + dd] * wreg[dd]; a1 += pw[(c + 1) * 64 + dd] * wreg[dd]; }
                *(unsigned*)(wt + (size_t)n * DM + g * 64 + c) = pk2(a0, a1); }
}
__device__ __forceinline__ void filler(unsigned char* lds, ArgsP a, int first_wg, int lo0, int hi0, int lo1, int hi1) {
    ARGS_OPAQUE(a);
    int tid = threadIdx.x; asm volatile("" : "+v"(tid));
    if ((int)gridDim.x <= first_wg) first_wg = 0;
    if ((int)blockIdx.x < first_wg) return;
    const int lane = tid & 63, wave = tid >> 6; float* scr = (float*)(lds + wave * 16384);
    const int fw = ((int)blockIdx.x - first_wg) * 8 + wave, nfw = ((int)gridDim.x - first_wg) * 8, n0 = hi0 - lo0, n1 = hi1 - lo1;
    for (int j = fw; j < n0 + n1; j += nfw) conv_item(a, j < n0 ? lo0 + j : lo1 + (j - n0), scr, lane);
}
__device__ __forceinline__ void prologue(unsigned char* lds, ArgsP a) {
    int tid = threadIdx.x; asm volatile("" : "+v"(tid));
    const int lane = tid & 63, wave = tid >> 6;
    float* scr = (float*)(lds + wave * 16384);
    const int gw = blockIdx.x * 8 + wave, NGW = gridDim.x * 8;
    for (int j = gw; j < I_P + I_GU; j += NGW) { if (j < I_P) fold_item(a, j, lane); else conv_item(a, j - I_P, scr, lane); }
    rms_phase<false>(lds, a->in[0], a->in[1], a->out, (bf16u*)(a->ws + WS_XN), nullptr, nullptr, nullptr, nullptr, nullptr);
}

__device__ __forceinline__ void scan_ck2(float* ck2, float* wsum, int n, const float* src0, int n0, const float* src1, int n1) {
    int tid = threadIdx.x; asm volatile("" : "+v"(tid));
    const int lane = tid & 63, wave = tid >> 6;
    const int per = (n + 511) >> 9, base = tid * per;
    float v[9]; float loc = 0.f;
#pragma unroll
    for (int k = 0; k < 9; ++k) { const int i = base + k; v[k] = 0.f; if (k < per) { if (i < n0) v[k] = src0[(size_t)i * 8]; else if (i < n0 + n1) v[k] = src1[(size_t)(i - n0) * 8]; } }
#pragma unroll
    for (int k = 0; k < 9; ++k) loc += v[k];
    float inc = loc;
#pragma unroll
    for (int o = 1; o < 64; o <<= 1) { const float t = __builtin_bit_cast(float, __builtin_amdgcn_ds_bpermute(((lane - o) & 63) << 2, __builtin_bit_cast(int, inc))); if (lane >= o) inc += t; }
    if (lane == 63) wsum[wave] = inc;
    __syncthreads();
    float run = inc - loc;
    for (int w = 0; w < wave; ++w) run += wsum[w];
#pragma unroll
    for (int k = 0; k < 9; ++k) { if (k < per) { const int i = base + k; run += v[k]; if (i < n) ck2[i] = run * LOG2E; } }
    __syncthreads();
}

__device__ __forceinline__ void poolconv_unit(unsigned char* lds, ArgsP a, int l, int tt) {
    int tid = threadIdx.x; asm volatile("" : "+v"(tid));
    const int lane = tid & 63, wave = tid >> 6;
    const bool samp = tt >= 1024; const int b = samp ? tt - 1024 : tt >> 6, t0 = samp ? 0 : (tt & 63) * 32; const size_t row0 = (size_t)tt * 32;
    const float* UP = (const float*)(a->ws + WS_UP); const float* Z = (const float*)(a->ws + WS_Z); bf16u* Y = (bf16u*)(a->ws + WS_XN);
    float* pb = (float*)lds; float* yb = (float*)(lds + 65536);
    const bool last = samp || t0 == SEQ - 32;
    f32x4 pv[6], zv[8];
#pragma unroll
    for (int q = 0; q < 6; ++q) { const int e = tid + 512 * q, j = e >> 6, c4 = (e & 63) * 4, tm = t0 - 15 + j; pv[q] = (f32x4){0.f, 0.f, 0.f, 0.f};
        if (e < 47 * 64) { if (tm >= 0) pv[q] = *(const f32x4*)(UP + (row0 + j - 15) * 256 + c4); else if (samp) pv[q] = *(const f32x4*)(a->in[2] + ((size_t)(l * 8 + b) * 15 + j) * 256 + c4); } }
#pragma unroll
    for (int q = 0; q < 8; ++q) { const int e = tid + 512 * q, i = e >> 6, c4 = (e & 63) * 4, tm = t0 - 30 + i; zv[q] = (f32x4){0.f, 0.f, 0.f, 0.f};
        if (e < 62 * 64) { if (tm >= 0) zv[q] = *(const f32x4*)(Z + (row0 + i - 30) * 256 + c4); else if (samp) zv[q] = *(const f32x4*)(a->in[3] + ((size_t)(l * 8 + b) * 30 + i) * 256 + c4); } }
    const int c = tid & 255, half = tid >> 8;
    float cw[31];
#pragma unroll
    for (int j = 0; j < 31; ++j) cw[j] = a->in[15][(size_t)(l * 31 + j) * 256 + c];
    const float cb = a->in[16][l * 256 + c];
#pragma unroll
    for (int q = 0; q < 6; ++q) { const int e = tid + 512 * q; if (e < 47 * 64) *(f32x4*)(pb + (e >> 6) * 256 + (e & 63) * 4) = pv[q]; }
    __syncthreads();
    { const int w = 2 << (c >> 6);
      const int r0p = half * 16; float xr[31];
#pragma unroll
      for (int i = 0; i < 31; ++i) xr[i] = pb[(r0p + i) * 256 + c];
#pragma unroll
      for (int t = 0; t < 16; ++t) { float s = 0.f;
#pragma unroll
          for (int k = 0; k < 16; ++k) { if (k < w) s += xr[t + 15 - k]; }
          const int tl = r0p + t, cnt = samp ? w : min(t0 + tl + 1, w); const float d = s * __builtin_amdgcn_rcpf((float)cnt) - xr[t + 15];
          Y[(row0 + tl) * 1024 + c] = (bf16u)f2bf(d); }
      if (last) { float* dst = samp ? a->out + O_POOLS + (size_t)(l * 8 + b) * 15 * 256 : a->out + O_POOLP + (size_t)(l * 16 + b) * 15 * 256;
          for (int e = tid; e < 15 * 256; e += 512) dst[e] = pb[32 * 256 + e]; } }
    __syncthreads();
    float* zb = pb;
#pragma unroll
    for (int q = 0; q < 8; ++q) { const int e = tid + 512 * q; if (e < 62 * 64) *(f32x4*)(zb + (e >> 6) * 256 + (e & 63) * 4) = zv[q]; }
    __syncthreads();
    { const int r0 = half * 16; float acc[16];
#pragma unroll
      for (int t = 0; t < 16; ++t) acc[t] = cb;
#pragma unroll
      for (int i = 0; i < 46; ++i) { const float zq = zb[(r0 + i) * 256 + c];
#pragma unroll
          for (int t = 0; t < 16; ++t) { if (i - t >= 0 && i - t < 31) acc[t] += zq * cw[i - t]; } }
#pragma unroll
      for (int t = 0; t < 16; ++t) yb[(r0 + t) * 256 + c] = acc[t];
      if (last) { float* dst = samp ? a->out + O_CONVS + (size_t)(l * 8 + b) * 30 * 256 : a->out + O_CONVP + (size_t)(l * 16 + b) * 30 * 256;
          for (int e = tid; e < 30 * 256; e += 512) dst[e] = zb[32 * 256 + e]; } }
    __syncthreads();
    { const f32x4 g = *(const f32x4*)(a->in[17] + l * 256 + lane * 4), be = *(const f32x4*)(a->in[18] + l * 256 + lane * 4);
      f32x4 vq[4]; float s1[4], s2[4];
#pragma unroll
      for (int q = 0; q < 4; ++q) { vq[q] = *(const f32x4*)(yb + (wave * 4 + q) * 256 + lane * 4); s1[q] = (vq[q].x + vq[q].y) + (vq[q].z + vq[q].w); }
#pragma unroll
      for (int q = 0; q < 4; ++q) s1[q] = wave_sum(s1[q]) * (1.0f / 256.0f);
#pragma unroll
      for (int q = 0; q < 4; ++q) { vq[q] = vq[q] - s1[q]; s2[q] = (vq[q].x * vq[q].x + vq[q].y * vq[q].y) + (vq[q].z * vq[q].z + vq[q].w * vq[q].w); }
#pragma unroll
      for (int q = 0; q < 4; ++q) s2[q] = wave_sum(s2[q]) * (1.0f / 256.0f);
#pragma unroll
      for (int q = 0; q < 4; ++q) { const int row = wave * 4 + q; const float rs = rsqrtf(s2[q] + 1e-6f);
          f32x4 y = vq[q] * rs * g + be; y.x = y.x * pg8::sigmoid_f(y.x); y.y = y.y * pg8::sigmoid_f(y.y); y.z = y.z * pg8::sigmoid_f(y.z); y.w = y.w * pg8::sigmoid_f(y.w);
          u32x2 w; w.x = pk2(y.x, y.y); w.y = pk2(y.z, y.w); *(u32x2*)(Y + (row0 + row) * 1024 + 256 + lane * 4) = w; } }
    __syncthreads();
}

constexpr int N_ATT_S = 64, N_ATT_P = 1024, N_PC = 1032, N_MIX_UNITS = N_ATT_S + N_ATT_P + N_PC;
__device__ __forceinline__ void mix_phase(unsigned char* lds, ArgsP a, int l) {
    ARGS_OPAQUE(a);
    const int tid = threadIdx.x;
    volatile unsigned* MISC = (volatile unsigned*)(lds + MISC_OFF);
    unsigned* ctr = (unsigned*)(a->ws + WS_CTL) + 64 * (1 + l);
    float* ck2 = (float*)(lds + CK2_OFF); float* wsum = (float*)(lds + CK2_OFF + SKV * 4);
    bf16u* Y = (bf16u*)(a->ws + WS_XN);
    const float* lfP = a->out + O_FP + (size_t)l * MP * 8; const float* lfS = a->out + O_FS + (size_t)l * MS * 8;
    if (tid == 0) MISC[0] = atomicAdd(ctr, 1u);
    for (;;) {
        __syncthreads();
        const int idx = __builtin_amdgcn_readfirstlane((int)MISC[0]);
        if (idx >= N_MIX_UNITS) break;
        unsigned nxt = 0u; if (tid == 0) nxt = atomicAdd(ctr, 1u);
        __syncthreads();
        if (idx < N_ATT_S + N_ATT_P) {
            const attn_body::bf16 *Q, *K, *V; attn_body::bf16* O; int NT, smask;
            if (idx < N_ATT_S) {
                const int b = idx >> 3, h = idx & 7;
                scan_ck2(ck2, wsum, SKV, a->in[6] + ((size_t)(l * 8 + b) * PAST) * 8 + h, PAST, lfS + (size_t)b * DECS * 8 + h, DECS);
                Q = (const attn_body::bf16*)(a->ws + WS_QS) + (size_t)b * 256 * 512 + h * 64;
                K = (const attn_body::bf16*)(a->ws + WS_KS + (size_t)(2 * l) * KS_STRIDE) + (size_t)b * SKV * 512 + h * 64;
                V = (const attn_body::bf16*)(a->ws + WS_KS + (size_t)(2 * l + 1) * KS_STRIDE) + (size_t)b * SKV * 512 + h * 64;
                O = (attn_body::bf16*)Y + ((size_t)MP + b * DECS - 128) * 1024 + 512 + h * 64;
                NT = SKV / 64; smask = 1 << 4;
            } else {
                const int j = idx - N_ATT_S, qb = 7 - (j >> 7), bh = j & 127, b = bh >> 3, h = bh & 7;
                scan_ck2(ck2, wsum, 256 * (qb + 1), lfP + (size_t)b * SEQ * 8 + h, 256 * (qb + 1), nullptr, 0);
                const size_t r0 = (size_t)b * SEQ;
                Q = (const attn_body::bf16*)(a->ws + WS_QP) + (r0 + qb * 256) * 512 + h * 64;
                K = (const attn_body::bf16*)(a->ws + WS_KP) + r0 * 512 + h * 64;
                V = (const attn_body::bf16*)(a->ws + WS_VP) + r0 * 512 + h * 64;
                O = (attn_body::bf16*)Y + (r0 + qb * 256) * 1024 + 512 + h * 64;
                NT = 4 * (qb + 1); smask = 0xff;
            }
#ifndef DIS_ATT
            attn_body::attn_unit<8>(Q, K, V, O, NT, smask, (attn_body::lds_cfptr)ck2, (char*)lds);
#endif
        } else {
#ifndef DIS_PC
            poolconv_unit(lds, a, l, idx - N_ATT_S - N_ATT_P);
#endif
        }
        if (tid == 0) MISC[0] = nxt;
    }
}

#define XB_TMO      128
#define XB_XCNT(j)  (256  + 64 * (j))
#define XB_XSUB(j)  (1280 + 64 * (j))
#define XB_XGEN(j)  (2304 + 64 * (j))
#define XB_TOP      3328
#define XB_TOPGEN   3392
#define XCD_BAR_WORDS 3456
#define XB_SPIN_CAP (1u << 18)

__device__ __forceinline__ unsigned xb_ld(unsigned* p)              { return __hip_atomic_load(p, __ATOMIC_RELAXED, __HIP_MEMORY_SCOPE_AGENT); }
__device__ __forceinline__ unsigned xb_add(unsigned* p, unsigned v) { return __hip_atomic_fetch_add(p, v, __ATOMIC_RELAXED, __HIP_MEMORY_SCOPE_AGENT); }
__device__ __forceinline__ unsigned xb_xcc_id() { return (unsigned)__builtin_amdgcn_s_getreg((3 << 11) | 20) & 0xFu; }
#define XB_SPIN(cond, bar) do { unsigned _sp = 0; while (cond) { __builtin_amdgcn_s_sleep(0); \
    if ((++_sp & 255u) == 0u) { if (xb_ld(&(bar)[XB_TMO])) break; if (_sp > XB_SPIN_CAP) { atomicAdd(&(bar)[XB_TMO], 1u); break; } } } } while (0)

struct XcdBarrier {
    unsigned* bar; unsigned x;
    volatile LAS unsigned* st;
};

__device__ __forceinline__ XcdBarrier xcd_barrier_post(unsigned* bar, volatile LAS unsigned* st) {
    XcdBarrier b; b.bar = bar; b.x = xb_xcc_id(); b.st = st;
    if (threadIdx.x == 0) (void)xb_add(&bar[XB_XCNT(b.x)], 1u);
    return b;
}
__device__ __forceinline__ void xcd_barrier_complete(unsigned* bar, unsigned x, unsigned& nloc, unsigned& nx) {
    const unsigned G = gridDim.x * gridDim.y * gridDim.z;
    unsigned sum, cnt, mine, sp = 0u;
    for (;;) {
        sum = 0u; cnt = 0u; mine = 0u;
#pragma unroll
        for (unsigned j = 0; j < 16; ++j) { const unsigned c = xb_ld(&bar[XB_XCNT(j)]); sum += c; cnt += (c > 0u) ? 1u : 0u; mine = (j == x) ? c : mine; }
        if (sum == G) break;
        __builtin_amdgcn_s_sleep(1);
        if ((++sp & 255u) == 0u) { if (xb_ld(&bar[XB_TMO])) break; if (sp > XB_SPIN_CAP) { atomicAdd(&bar[XB_TMO], 1u); break; } }
    }
    nloc = mine > 0u ? mine : 1u; nx = cnt > 0u ? cnt : 1u;
}

__device__ __forceinline__ void xcd_barrier(const XcdBarrier& b) {
    asm volatile("s_waitcnt vmcnt(0)" ::: "memory");
    __syncthreads();
    if (threadIdx.x == 0) {
        unsigned* bar = b.bar;
        __builtin_amdgcn_s_waitcnt(0);
        unsigned nloc = b.st[0], nx = b.st[1];
        if (nloc == 0u) { xcd_barrier_complete(bar, b.x, nloc, nx); b.st[0] = nloc; b.st[1] = nx; }
        const unsigned old = xb_add(&bar[XB_XSUB(b.x)], 1u);
        const unsigned gen = old / nloc;
        if (old + 1u == (gen + 1u) * nloc) {
            __builtin_amdgcn_fence(__ATOMIC_RELEASE, "agent");
            asm volatile("s_waitcnt vmcnt(0)" ::: "memory");
            const unsigned og = xb_add(&bar[XB_TOP], 1u);
            const unsigned tg = og / nx;
            if (og + 1u == (tg + 1u) * nx) xb_add(&bar[XB_TOPGEN], 1u);
            else XB_SPIN(xb_ld(&bar[XB_TOPGEN]) == tg, bar);
            __builtin_amdgcn_fence(__ATOMIC_ACQUIRE, "agent");
            xb_add(&bar[XB_XGEN(b.x)], 1u);
            asm volatile("s_waitcnt vmcnt(0)" ::: "memory");
        } else {
            XB_SPIN(xb_ld(&bar[XB_XGEN(b.x)]) == gen, bar);
            __builtin_amdgcn_fence(__ATOMIC_ACQUIRE, "agent");
            asm volatile("s_waitcnt vmcnt(0)" ::: "memory");
        }
    }
    __syncthreads();
}

template <class Epi> __device__ __forceinline__ void run_gemm(unsigned char* lds, const bf16u* A, const bf16u* Bt, int M, int N, int K, const Epi& E) {
    pg8::Gemm g{A, Bt, M, N, K, K}; pg8::StaticOrder S; S.init(M, N, (int)gridDim.x, (int)blockIdx.x);
    pg8::gemm_phase<Epi, pg8::StaticOrder, true, true>((LAS unsigned char*)lds, g, S, E);
}
__device__ __forceinline__ void run_gemm_resid(unsigned char* lds, const bf16u* A, const bf16u* Bt, int K, int nk, const float* Bp, float* X, float alpha) {
    { pg8::EpiResid E{Bp, X, DM, alpha}; run_gemm(lds, A, Bt, MP, DM, K, E); }
    { pg8::Gemm g{A, Bt, MT, DM, K / nk, K}; pg8::SplitOrder S{DM / 256, nk, K / nk, MP / 256, (int)blockIdx.x}; pg8::EpiResidAtomic E{X, DM, alpha};
      pg8::gemm_phase<pg8::EpiResidAtomic, pg8::SplitOrder, false, true>((LAS unsigned char*)lds, g, S, E); }
}

__global__ void __launch_bounds__(512, 2) mk_fwd(Args kargs) {
    extern __shared__ __attribute__((aligned(16))) unsigned char lds[];
    cg::grid_group grid = cg::this_grid();
    ArgsP a = (ArgsP)__builtin_amdgcn_kernarg_segment_ptr();
    volatile LAS unsigned* MISCW = (volatile LAS unsigned*)((LAS unsigned char*)lds + MISC_OFF);
    if (threadIdx.x < 16) MISCW[threadIdx.x] = 0u;
    __syncthreads();
    XcdBarrier bar = xcd_barrier_post((unsigned*)(a->ws + WS_CTL) + CW_BAR, MISCW + 8);
    const int lo = a->ph_lo, hi = a->ph_hi; int ph = 0;
    if (lo < 0) grid.sync();
#define PH_IN (ph >= lo && ph < hi)
#define PH_END do { if (ph >= lo && ph + 1 < hi) { if (!MK_PER_PHASE) xcd_barrier(bar); } ++ph; } while (0)
    bf16u* XN = (bf16u*)(a->ws + WS_XN); bf16u* H = (bf16u*)(a->ws + WS_H);
#ifndef DIS_PRO
    if (PH_IN) prologue(lds, a);
#endif
    PH_END;
    for (int hl = 0; hl < 4; ++hl) {
        const int l = hl >> 1, f = hl & 1;
        ARGS_OPAQUE(a);
        unsigned char* wl = a->ws + WS_W + (size_t)l * WL_STRIDE;
#ifndef DIS_G1
        if (PH_IN) { pg8::EpiSwiglu E{H, DFF}; run_gemm(lds, XN, (const bf16u*)(wl + (f ? WL_GU2 : WL_GU1)), MT, NGU, DM, E);
            if (hl == 0) filler(lds, a, 22, I_GU, I_GU + I_D + I_IN, I_W, I_W + I_C / 2);
            else if (hl == 1) filler(lds, a, 22, I_L, I_L + I_GU + I_D + I_IN, 0, 0);
            else if (hl == 2) filler(lds, a, 22, I_W + I_C / 2, I_W + I_C, 0, 0); }
#endif
        PH_END;
#ifndef DIS_G2
        if (PH_IN) run_gemm_resid(lds, H, (const bf16u*)(wl + (f ? WL_D2 : WL_D1)), DFF, 11, hl == 0 ? a->in[0] : a->out, a->out, 0.5f);
#endif
        PH_END;
        if (f == 0) {
#ifndef DIS_RMS
            if (PH_IN) rms_phase<true>(lds, a->out, a->out + (size_t)MP * DM, nullptr, XN, a->in[10] + l * DM, a->in[11] + (size_t)l * DM * DIN, a->in[21] + l * 8,
                                       a->out + O_FP + (size_t)l * MP * 8, a->out + O_FS + (size_t)l * MS * 8);
#endif
            PH_END;
#ifndef DIS_G3
            if (PH_IN) {
                pg8::EpiMixIn E{a->ws, a->out, a->in[19] + l * 64, a->in[20] + l * 64, l, attn_body::C2};
                run_gemm(lds, XN, (const bf16u*)(wl + WL_IN), MT, NMIX, DM, E);
                filler(lds, a, 137, l * I_L + I_GU + I_D + I_IN, (l + 1) * I_L, 0, 0);
            }
#endif
            PH_END;
#ifndef DIS_MIX
            if (PH_IN) mix_phase(lds, a, l);
#endif
            PH_END;
#ifndef DIS_G4
            if (PH_IN) run_gemm_resid(lds, XN, (const bf16u*)(wl + WL_OUT), DM, 4, a->out, a->out, 1.0f);
#endif
            PH_END;
            if (PH_IN) rms_phase<false>(lds, a->out, a->out + (size_t)MP * DM, nullptr, XN, nullptr, nullptr, nullptr, nullptr, nullptr);
            PH_END;
        } else if (l == 0) {
            if (PH_IN) rms_phase<false>(lds, a->out, a->out + (size_t)MP * DM, nullptr, XN, nullptr, nullptr, nullptr, nullptr, nullptr);
            PH_END;
        }
    }
#undef PH_IN
#undef PH_END
}
constexpr int N_PHASES = 1 + 2 * (2 + 5 + 2) + 1;

extern "C" void kernel_launch(void* const* d_in, const int* in_sizes, int n_in, void* d_out, int out_size, void* d_ws, size_t ws_size, hipStream_t stream) {
    static int grid = 0;
    if (grid == 0) {
        if (n_in != 25 || out_size != (int)O_END || ws_size < WS_END) { fprintf(stderr, "kernel_launch: unexpected shapes: n_in %d out %d ws %zu (need %zu)\n", n_in, out_size, ws_size, (size_t)WS_END); grid = -1; return; }
        int dev = 0, cus = 0, per_cu = 0;
        if (hipGetDevice(&dev) != hipSuccess || hipDeviceGetAttribute(&cus, hipDeviceAttributeMultiprocessorCount, dev) != hipSuccess) { grid = -1; return; }
        if (hipFuncSetAttribute((const void*)mk_fwd, hipFuncAttributeMaxDynamicSharedMemorySize, LDS_BYTES) != hipSuccess) { fprintf(stderr, "kernel_launch: hipFuncSetAttribute failed\n"); grid = -1; return; }
        if (hipOccupancyMaxActiveBlocksPerMultiprocessor(&per_cu, (const void*)mk_fwd, 512, LDS_BYTES) != hipSuccess || per_cu < 1) { fprintf(stderr, "kernel_launch: occupancy query says %d\n", per_cu); per_cu = 1; }
        (void)hipGetLastError();
        grid = cus;
        fprintf(stderr, "kernel_launch: grid %d (occupancy %d per CU)\n", grid, per_cu);
    }
    if (grid < 0) return;
    (void)hipMemsetAsync((char*)d_ws + WS_CTL, 0, CTL_BYTES, stream);
    Args a{};
    for (int i = 0; i < 25; ++i) a.in[i] = (const float*)d_in[i];
    a.out = (float*)d_out; a.ws = (unsigned char*)d_ws;
#if MK_PER_PHASE
    for (int p = 0; p < N_PHASES; ++p) { a.ph_lo = p; a.ph_hi = p + 1; hipLaunchKernelGGL(mk_fwd, dim3(grid), dim3(512), LDS_BYTES, stream, a); }
#else
    a.ph_lo = 0; a.ph_hi = N_PHASES;
    void* args[] = {&a};
    const hipError_t e = hipLaunchCooperativeKernel((const void*)mk_fwd, dim3(grid), dim3(512), args, LDS_BYTES, stream);
    if (e != hipSuccess) fprintf(stderr, "kernel_launch: cooperative launch failed: %s (grid %d)\n", hipGetErrorString(e), grid);
#endif
}
```
